# Optimizing an MI355X kernel written in HIP

```python
import math
import jax, jax.numpy as jnp
from jax import lax
import numpy as np

D_MODEL = 1024
BATCH = 4
SEQ = 4096
DEPTH = 1

ATTN_HEAD_DIM = 64
ATTN_Q_HEADS = 16
ATTN_KV_HEADS = 2
ATTN_GROUP = ATTN_Q_HEADS // ATTN_KV_HEADS
ATTN_WIDTH = ATTN_Q_HEADS * ATTN_HEAD_DIM
ATTN_KV_WIDTH = ATTN_KV_HEADS * ATTN_HEAD_DIM
WINDOW = 128
ATTN_BLOCK = 128
HGRN_EXPAND = 128
HGRN_HEADS = D_MODEL // HGRN_EXPAND
HGRN_K = HGRN_EXPAND
HGRN_V = D_MODEL // HGRN_HEADS
HGRN_KEY_WIDTH = HGRN_HEADS * HGRN_K
HGRN_WIDTH = HGRN_HEADS * HGRN_V
CHUNK = 64
FFN_HIDDEN = -(-(8 * D_MODEL) // (3 * 256)) * 256
EPS = 1e-6
NEG_INF = -1e30
IN_SPLITS = (ATTN_WIDTH, ATTN_KV_WIDTH, ATTN_KV_WIDTH,
             HGRN_KEY_WIDTH, HGRN_KEY_WIDTH, HGRN_WIDTH, HGRN_WIDTH,
             D_MODEL, D_MODEL)
IN_WIDTH = sum(IN_SPLITS)

kernel_name = "hybrid_swa_sink_hgrn2_gated_block"


def rmsnorm(x, g):
    xf = x.astype(jnp.float32)
    y = xf * lax.rsqrt(jnp.mean(xf * xf, axis=-1, keepdims=True) + EPS)
    return (y * g.astype(jnp.float32)).astype(x.dtype)


def split_columns(p):
    idx = np.cumsum(np.array(IN_SPLITS))[:-1].tolist()
    return jnp.split(p, idx, axis=-1)


def sliding_window_sink_attention(q, k, v, sinks):
    B, S = q.shape[0], q.shape[1]
    nb = S // ATTN_BLOCK
    qb = q.reshape(B, nb, ATTN_BLOCK, ATTN_KV_HEADS, ATTN_GROUP, ATTN_HEAD_DIM)
    kb = k.reshape(B, nb, ATTN_BLOCK, ATTN_KV_HEADS, ATTN_HEAD_DIM)
    vb = v.reshape(B, nb, ATTN_BLOCK, ATTN_KV_HEADS, ATTN_HEAD_DIM)

    def with_prev(t):
        prev = jnp.concatenate([jnp.zeros_like(t[:, :1]), t[:, :-1]], axis=1)
        return jnp.concatenate([prev, t], axis=2)

    kw, vw = with_prev(kb), with_prev(vb)
    scale = 1.0 / math.sqrt(ATTN_HEAD_DIM)
    scores = jnp.einsum('bnqhgd,bnkhd->bnhgqk', qb, kw).astype(jnp.float32) * scale
    qi = jnp.arange(ATTN_BLOCK)[:, None]
    kj = jnp.arange(2 * ATTN_BLOCK)[None, :]
    rel = qi + ATTN_BLOCK - kj
    key_pos = jnp.arange(nb)[:, None, None] * ATTN_BLOCK - ATTN_BLOCK + kj[None]
    valid = (rel >= 0)[None] & (rel < WINDOW)[None] & (key_pos >= 0)
    scores = jnp.where(valid[None, :, None, None], scores, NEG_INF)
    sink = jnp.broadcast_to(
        sinks.astype(jnp.float32).reshape(1, 1, ATTN_KV_HEADS, ATTN_GROUP, 1, 1),
        scores.shape[:-1] + (1,))
    probs = jax.nn.softmax(jnp.concatenate([scores, sink], axis=-1), axis=-1)[..., :-1]
    out = jnp.einsum('bnhgqk,bnkhd->bnqhgd', probs.astype(v.dtype), vw)
    return out.reshape(B, S, ATTN_WIDTH)


def hgrn2_chunkwise(q, k, v, log_f):
    B, S, H, K = q.shape
    V = v.shape[-1]
    n = S // CHUNK

    def to_chunks(t):
        return t.reshape(B, n, CHUNK, H, t.shape[-1]).transpose(1, 0, 3, 2, 4)

    causal = jnp.tril(jnp.ones((CHUNK, CHUNK), dtype=bool))

    def step(state, inp):
        qc, kc, vc, gc = inp
        b = jnp.cumsum(gc, axis=2)
        b_mid = b[:, :, CHUNK // 2 - 1:CHUNK // 2]
        b_last = b[:, :, -1:]
        a = jnp.einsum('bhck,bhsk->bhcs', qc * jnp.exp(b - b_mid), kc * jnp.exp(b_mid - b))
        a = jnp.where(causal, a, 0.0)
        o = (jnp.einsum('bhcs,bhsv->bhcv', a, vc)
             + jnp.einsum('bhck,bhkv->bhcv', qc * jnp.exp(b), state))
        state = (jnp.exp(b_last)[:, :, 0, :, None] * state
                 + jnp.einsum('bhsk,bhsv->bhkv', kc * jnp.exp(b_last - b), vc))
        return state, o

    s0 = jnp.zeros((B, H, K, V), jnp.float32)
    _, o = lax.scan(step, s0, (to_chunks(q), to_chunks(k), to_chunks(v), to_chunks(log_f)))
    return o.transpose(1, 0, 3, 2, 4).reshape(B, S, H, V)


def hgrn2_branch(hq, hf, hi, hg, lb, norm_g):
    B, S = hq.shape[0], hq.shape[1]
    fp = hf.astype(jnp.float32)
    log_f = jnp.log(lb + (1.0 - lb) * jax.nn.sigmoid(fp))
    k = (1.0 - lb) * jax.nn.sigmoid(-fp)
    q = jax.nn.silu(hq.astype(jnp.float32))
    shp_k = (B, S, HGRN_HEADS, HGRN_K)
    o = hgrn2_chunkwise(q.reshape(shp_k), k.reshape(shp_k),
                        hi.astype(jnp.float32).reshape(B, S, HGRN_HEADS, HGRN_V),
                        log_f.reshape(shp_k))
    o = o * lax.rsqrt(jnp.mean(o * o, axis=-1, keepdims=True) + EPS)
    o = o.reshape(B, S, HGRN_WIDTH) * norm_g.astype(jnp.float32)
    o = o * jax.nn.sigmoid(hg.astype(jnp.float32))
    return o.astype(hq.dtype)


def setup_inputs(seed: int = 0) -> dict:
    key = jax.random.key(seed)
    ks = jax.random.split(key, 20)
    D, F = D_MODEL, FFN_HIDDEN
    nrm = lambda k, shape, fan_in: jax.random.normal(k, shape, jnp.float32) * fan_in ** -0.5
    gain = lambda k, shape: 1.0 + 0.05 * jax.random.normal(k, shape, jnp.float32)
    return {
        "x": jax.random.normal(ks[0], (BATCH, SEQ, D), jnp.float32),
        "norm_mix_g": gain(ks[1], (DEPTH, D)),
        "w_in": nrm(ks[2], (DEPTH, D, IN_WIDTH), D),
        "b_in": 0.01 * jax.random.normal(ks[3], (DEPTH, IN_WIDTH), jnp.float32),
        "attn_sinks": 0.5 * jax.random.normal(ks[4], (DEPTH, ATTN_Q_HEADS), jnp.float32),
        "hgrn_lb_logits": gain(ks[5], (DEPTH + 1, HGRN_KEY_WIDTH)),
        "hgrn_norm_g": gain(ks[6], (DEPTH, HGRN_WIDTH)),
        "w_branch_attn": nrm(ks[7], (DEPTH, ATTN_WIDTH, D), ATTN_WIDTH),
        "w_branch_hgrn": nrm(ks[8], (DEPTH, HGRN_WIDTH, D), HGRN_WIDTH),
        "w_out": nrm(ks[9], (DEPTH, D, D), D),
        "norm_ffn_g": gain(ks[10], (DEPTH, D)),
        "w_ffn_gate": nrm(ks[11], (DEPTH, D, F), D),
        "w_ffn_up": nrm(ks[12], (DEPTH, D, F), D),
        "w_ffn_down": nrm(ks[13], (DEPTH, F, D), F),
        "norm_final_g": gain(ks[14], (D,)),
    }


def reference(x, norm_mix_g, w_in, b_in, attn_sinks, hgrn_lb_logits, hgrn_norm_g,
              w_branch_attn, w_branch_hgrn, w_out, norm_ffn_g, w_ffn_gate, w_ffn_up,
              w_ffn_down, norm_final_g):
    lb_all = jnp.cumsum(jax.nn.softmax(hgrn_lb_logits.astype(jnp.float32), axis=0), axis=0)
    h = x
    for layer in range(DEPTH):
        u = rmsnorm(h, norm_mix_g[layer])
        p = jnp.einsum('bsd,de->bse', u, w_in[layer]) + b_in[layer]
        aq, ak, av, hq, hf, hi, hg, gate_a, gate_b = split_columns(p)
        y_attn = sliding_window_sink_attention(aq, ak, av, attn_sinks[layer])
        y_hgrn = hgrn2_branch(hq, hf, hi, hg, lb_all[layer], hgrn_norm_g[layer])
        ya = jnp.einsum('bse,ed->bsd', y_attn, w_branch_attn[layer])
        yb = jnp.einsum('bse,ed->bsd', y_hgrn, w_branch_hgrn[layer])
        merged = jax.nn.sigmoid(gate_a) * ya + jax.nn.sigmoid(gate_b) * yb
        h = h + jnp.einsum('bsd,de->bse', merged, w_out[layer])
        u = rmsnorm(h, norm_ffn_g[layer])
        z = (jax.nn.silu(jnp.einsum('bsd,df->bsf', u, w_ffn_gate[layer]))
             * jnp.einsum('bsd,df->bsf', u, w_ffn_up[layer]))
        h = h + jnp.einsum('bsf,fd->bsd', z, w_ffn_down[layer])
    return rmsnorm(h, norm_final_g)
```

```cpp
#include <hip/hip_runtime.h>
#include <cstdio>
#include <cstdint>

namespace nv {
constexpr int D = 1024, NB = 4, S = 4096, INW = 7424, F = 2816;
constexpr int O_AQ = 0, O_AK = 1024, O_AV = 1152, O_HQ = 1280, O_HF = 2304, O_HI = 3328, O_HG = 4352, O_GA = 5376, O_GB = 6400;
constexpr float EPS = 1e-6f;

__global__ void k_rmsnorm(const float* __restrict__ x, const float* __restrict__ g, float* __restrict__ out) {
    const int row = blockIdx.x, t = threadIdx.x;
    const float4 v = ((const float4*)(x + (size_t)row * D))[t];
    float s = v.x * v.x + v.y * v.y + v.z * v.z + v.w * v.w;
    __shared__ float red[256];
    red[t] = s; __syncthreads();
    for (int o = 128; o > 0; o >>= 1) { if (t < o) red[t] += red[t + o]; __syncthreads(); }
    const float r = rsqrtf(red[0] / D + EPS);
    const float4 gv = ((const float4*)g)[t];
    float4 o4; o4.x = v.x * r * gv.x; o4.y = v.y * r * gv.y; o4.z = v.z * r * gv.z; o4.w = v.w * r * gv.w;
    ((float4*)(out + (size_t)row * D))[t] = o4;
}

__global__ void k_gemm(const float* __restrict__ A, int lda, const float* __restrict__ W, int ldw, const float* __restrict__ bias,
                       const float* __restrict__ res, int ldres, float* __restrict__ C, int ldc, int K) {
    __shared__ float As[16][65], Ws[16][65];
    const int t = threadIdx.x, tx = t & 15, ty = t >> 4, m0 = blockIdx.y * 64, n0 = blockIdx.x * 64;
    float acc[4][4] = {};
    for (int k0 = 0; k0 < K; k0 += 16) {
        for (int i = t; i < 64 * 16; i += 256) { const int r = i >> 4, c = i & 15; As[c][r] = A[(size_t)(m0 + r) * lda + k0 + c]; }
        for (int i = t; i < 16 * 64; i += 256) { const int r = i >> 6, c = i & 63; Ws[r][c] = W[(size_t)(k0 + r) * ldw + n0 + c]; }
        __syncthreads();
#pragma unroll
        for (int k = 0; k < 16; ++k) {
            float a[4], b[4];
#pragma unroll
            for (int i = 0; i < 4; ++i) { a[i] = As[k][ty * 4 + i]; b[i] = Ws[k][tx * 4 + i]; }
#pragma unroll
            for (int i = 0; i < 4; ++i)
#pragma unroll
                for (int j = 0; j < 4; ++j) acc[i][j] += a[i] * b[j];
        }
        __syncthreads();
    }
#pragma unroll
    for (int i = 0; i < 4; ++i)
#pragma unroll
        for (int j = 0; j < 4; ++j) {
            const int m = m0 + ty * 4 + i, n = n0 + tx * 4 + j;
            float v = acc[i][j]; if (bias) v += bias[n]; if (res) v += res[(size_t)m * ldres + n];
            C[(size_t)m * ldc + n] = v;
        }
}

__global__ void k_attn(const float* __restrict__ p, const float* __restrict__ sinks, float* __restrict__ y) {
    const int w = (blockIdx.x * blockDim.x + threadIdx.x) >> 6, d = threadIdx.x & 63;
    const int hq = w & 15, i = w >> 4, hkv = hq >> 3;
    const float q = p[(size_t)i * INW + O_AQ + hq * 64 + d];
    const int j0 = i - 127 < 0 ? 0 : i - 127;
    float m = sinks[hq], l = 1.f, o = 0.f;
    for (int j = j0; j <= i; ++j) {
        float s = q * p[(size_t)j * INW + O_AK + hkv * 64 + d];
#pragma unroll
        for (int x = 1; x < 64; x <<= 1) s += __shfl_xor(s, x);
        s *= 0.125f;
        const float mn = fmaxf(m, s), a = __expf(m - mn), e = __expf(s - mn);
        l = l * a + e; o = o * a + e * p[(size_t)j * INW + O_AV + hkv * 64 + d]; m = mn;
    }
    y[(size_t)i * D + hq * 64 + d] = o / l;
}

__global__ void k_hgrn(const float* __restrict__ p, const float* __restrict__ lbl, const float* __restrict__ ng, float* __restrict__ o_raw) {
    const int h = blockIdx.x >> 3, vs = blockIdx.x & 7, t = threadIdx.x, kq = t >> 4, v = t & 15;
    __shared__ float part[16][17];
    float lb[8], st[8];
#pragma unroll
    for (int i = 0; i < 8; ++i) { const int ch = h * 128 + kq * 8 + i; const float l0 = lbl[ch], l1 = lbl[1024 + ch]; const float mx = fmaxf(l0, l1); const float e0 = __expf(l0 - mx), e1 = __expf(l1 - mx); lb[i] = e0 / (e0 + e1); st[i] = 0.f; }
    for (int tok = 0; tok < S; ++tok) {
        const float* row = p + (size_t)tok * INW;
        const float vv = row[O_HI + h * 128 + vs * 16 + v];
        float po = 0.f;
#pragma unroll
        for (int i = 0; i < 8; ++i) { const int ch = h * 128 + kq * 8 + i; const float fp = row[O_HF + ch], hq = row[O_HQ + ch];
            const float sg = 1.f / (1.f + __expf(-fp)); const float f = lb[i] + (1.f - lb[i]) * sg; const float kk = (1.f - lb[i]) * (1.f - sg); const float q = hq / (1.f + __expf(-hq));
            st[i] = f * st[i] + kk * vv; po += q * st[i]; }
        part[kq][v] = po; __syncthreads();
        if (t < 16) { float s = 0.f;
#pragma unroll
            for (int i = 0; i < 16; ++i) s += part[i][t];
            o_raw[(size_t)tok * D + h * 128 + vs * 16 + t] = s; }
        __syncthreads();
    }
}
__global__ void k_hgrn_post(const float* __restrict__ o_raw, const float* __restrict__ p, const float* __restrict__ ng, float* __restrict__ y) {
    const int tok = blockIdx.x >> 3, h = blockIdx.x & 7, t = threadIdx.x;
    const float o = o_raw[(size_t)tok * D + h * 128 + t];
    __shared__ float red[128]; red[t] = o * o; __syncthreads();
    for (int s = 64; s > 0; s >>= 1) { if (t < s) red[t] += red[t + s]; __syncthreads(); }
    const float r = rsqrtf(red[0] / 128.f + EPS); const float hg = p[(size_t)tok * INW + O_HG + h * 128 + t];
    y[(size_t)tok * D + h * 128 + t] = o * r * ng[h * 128 + t] / (1.f + __expf(-hg));
}
__global__ void k_merge(const float* __restrict__ p, const float* __restrict__ ya, const float* __restrict__ yb, float* __restrict__ mg) {
    const int idx = blockIdx.x * blockDim.x + threadIdx.x; const int tok = idx >> 10, c = idx & 1023;
    const float ga = p[(size_t)tok * INW + O_GA + c], gb = p[(size_t)tok * INW + O_GB + c];
    mg[idx] = ya[idx] / (1.f + __expf(-ga)) + yb[idx] / (1.f + __expf(-gb));
}
__global__ void k_swiglu(const float* __restrict__ g, const float* __restrict__ u, float* __restrict__ z, int n) {
    const int idx = blockIdx.x * blockDim.x + threadIdx.x; if (idx < n) { const float a = g[idx]; z[idx] = a / (1.f + __expf(-a)) * u[idx]; }
}
}

extern "C" void kernel_launch(void* const* d_in, const int* in_sizes, int n_in, void* d_out, int out_size, void* d_ws, size_t ws_size, hipStream_t stream) {
    using namespace nv;
    const float* x = (const float*)d_in[0]; const float* g_mix = (const float*)d_in[1]; const float* w_in = (const float*)d_in[2]; const float* b_in = (const float*)d_in[3];
    const float* sinks = (const float*)d_in[4]; const float* lbl = (const float*)d_in[5]; const float* ng = (const float*)d_in[6];
    const float* wba = (const float*)d_in[7]; const float* wbh = (const float*)d_in[8]; const float* wout = (const float*)d_in[9]; const float* g_ffn = (const float*)d_in[10];
    const float* wg = (const float*)d_in[11]; const float* wu = (const float*)d_in[12]; const float* wd = (const float*)d_in[13]; const float* g_fin = (const float*)d_in[14];
    float* out = (float*)d_out; float* ws = (float*)d_ws;
    const size_t SD = (size_t)S * D;
    float* u = ws; float* p = u + SD; float* yat = p + (size_t)S * INW; float* yhg = yat + SD; float* oraw = yhg + SD; float* ya = oraw + SD; float* yb = ya + SD; float* mg = yb + SD; float* h1 = mg + SD;
    float* gt = p; float* up = p + (size_t)S * F; float* z = up + (size_t)S * F; float* h2 = ya;
    for (int b = 0; b < NB; ++b) {
        const float* xb = x + (size_t)b * SD; float* ob = out + (size_t)b * SD;
        k_rmsnorm<<<S, 256, 0, stream>>>(xb, g_mix, u);
        k_gemm<<<dim3(INW / 64, S / 64), 256, 0, stream>>>(u, D, w_in, INW, b_in, nullptr, 0, p, INW, D);
        k_attn<<<S * 16 / 4, 256, 0, stream>>>(p, sinks, yat);
        k_hgrn<<<64, 256, 0, stream>>>(p, lbl, ng, oraw);
        k_hgrn_post<<<S * 8, 128, 0, stream>>>(oraw, p, ng, yhg);
        k_gemm<<<dim3(D / 64, S / 64), 256, 0, stream>>>(yat, D, wba, D, nullptr, nullptr, 0, ya, D, D);
        k_gemm<<<dim3(D / 64, S / 64), 256, 0, stream>>>(yhg, D, wbh, D, nullptr, nullptr, 0, yb, D, D);
        k_merge<<<S * D / 256, 256, 0, stream>>>(p, ya, yb, mg);
        k_gemm<<<dim3(D / 64, S / 64), 256, 0, stream>>>(mg, D, wout, D, nullptr, xb, D, h1, D, D);
        k_rmsnorm<<<S, 256, 0, stream>>>(h1, g_ffn, u);
        k_gemm<<<dim3(F / 64, S / 64), 256, 0, stream>>>(u, D, wg, F, nullptr, nullptr, 0, gt, F, D);
        k_gemm<<<dim3(F / 64, S / 64), 256, 0, stream>>>(u, D, wu, F, nullptr, nullptr, 0, up, F, D);
        k_swiglu<<<(S * F + 255) / 256, 256, 0, stream>>>(gt, up, z, S * F);
        k_gemm<<<dim3(D / 64, S / 64), 256, 0, stream>>>(z, F, wd, D, nullptr, h1, D, h2, D, F);
        k_rmsnorm<<<S, 256, 0, stream>>>(h2, g_fin, ob);
    }
}
```

```cpp
#include <hip/hip_runtime.h>
#include <hip/hip_bf16.h>
#include <cstdio>
#include <cstdint>
#include <cmath>

namespace pg8 {
#define PG8_LAS __attribute__((address_space(3)))
typedef unsigned short bf16_t;
typedef short bf16x8 __attribute__((ext_vector_type(8)));
typedef float f32x4 __attribute__((ext_vector_type(4)));
typedef unsigned u32x4 __attribute__((ext_vector_type(4)));
constexpr int BM = 256, BK = 64, HALF = 128, HTB = HALF * BK * 2  , STAGE_BYTES = 8 * HTB, NXCD = 8, WGM = 8;

__host__ __device__ __forceinline__ int lds_byte(int r, int c) { const int st = (r >> 4) * 2 + (c >> 5), rr = r & 15, cc = c & 31, ob = rr * 64 + cc * 2; return st * 1024 + (ob ^ (((ob >> 9) & 1) << 5)); }
__host__ __device__ __forceinline__ void stage_rc(int b, int& R, int& C) { const int st = b / 1024, sb = b % 1024, swz = sb ^ (((sb >> 9) & 1) << 5); R = (st >> 1) * 16 + swz / 64; C = (st & 1) * 32 + (swz % 64) / 2; }
__host__ __device__ __forceinline__ int perm32(int rho) { const int n = rho >> 4, i = rho & 15; return 8 * (i >> 2) + 4 * n + (i & 3); }

struct Unit { int pm, pn; };
struct Gemm { const bf16_t* A; const bf16_t* Bt; int M, N, K, ld; const bf16_t* A2; const bf16_t* Bt2; int ks; };

struct StaticOrder {
    int nM, nN, nwg, G, c;
    __host__ __device__ void init(int M, int N, int G_, int c_) { nM = M / BM; nN = N / BM; nwg = nM * nN; G = G_; c = c_; }
    __host__ __device__ bool next(int i, Unit& u) const {
        const long L = (long)i * G + c; if (L >= nwg) return false;
        int wgid = (int)L; { const int q = nwg / NXCD, r = nwg % NXCD, xcd = wgid % NXCD, off = wgid / NXCD; wgid = (xcd < r ? xcd * (q + 1) : r * (q + 1) + (xcd - r) * q) + off; }
        const int nig = WGM * nN, gid = wgid / nig, fm = gid * WGM, gsz = (nM - fm) < WGM ? (nM - fm) : WGM;
        u.pm = fm + ((wgid % nig) % gsz); u.pn = (wgid % nig) / gsz; return true;
    }
    __device__ __forceinline__ void a_ready(const Unit&) const {}
    __device__ __forceinline__ void done(const Unit&) const {}
};

typedef float f32x2_t __attribute__((ext_vector_type(2))); typedef __bf16 bf16x2_t __attribute__((ext_vector_type(2)));
__device__ __forceinline__ unsigned cvt_pk_bf16(float lo, float hi) { const f32x2_t v = {lo, hi}; const bf16x2_t b = __builtin_convertvector(v, bf16x2_t); return __builtin_bit_cast(unsigned, b); }
__device__ __forceinline__ float bf_lo(unsigned w) { return __builtin_bit_cast(float, w << 16); }
__device__ __forceinline__ float bf_hi(unsigned w) { return __builtin_bit_cast(float, w & 0xffff0000u); }
constexpr float LOG2E = 1.4426950408889634f;
__device__ __forceinline__ float ex2(float x) { return __builtin_amdgcn_exp2f(x); }
__device__ __forceinline__ float rcp(float x) { return __builtin_amdgcn_rcpf(x); }
__device__ __forceinline__ float sigm(float x) { return rcp(1.f + ex2(-LOG2E * x)); }
__device__ __forceinline__ float dpp_shr(float x, int n) {
    int r;
    switch (n) { case 1: r = __builtin_amdgcn_update_dpp(0, __builtin_bit_cast(int, x), 0x111, 0xf, 0xf, true); break;
                 case 2: r = __builtin_amdgcn_update_dpp(0, __builtin_bit_cast(int, x), 0x112, 0xf, 0xf, true); break;
                 case 4: r = __builtin_amdgcn_update_dpp(0, __builtin_bit_cast(int, x), 0x114, 0xf, 0xf, true); break;
                 default: r = __builtin_amdgcn_update_dpp(0, __builtin_bit_cast(int, x), 0x118, 0xf, 0xf, true); break; }
    return __builtin_bit_cast(float, r);
}
__device__ __forceinline__ float row16_scan(float x) { x += dpp_shr(x, 1); x += dpp_shr(x, 2); x += dpp_shr(x, 4); x += dpp_shr(x, 8); return x; }

constexpr float C2 = 0.125f * LOG2E;
constexpr int IN_W = 7424;

struct EpiIn {
    static constexpr bool PERM = true, AFTER_DRAIN = false;
    bf16_t *AQ, *AK, *AV, *Q1, *K1, *V, *SG, *SR, *SB; float *BMID, *BLAST; const float *bias, *lbl;
    __device__ __forceinline__ void store8(bf16_t* p, const f32x4& v0, const f32x4& v1) const {
        u32x4 w; w.x = cvt_pk_bf16(v0[0], v0[1]); w.y = cvt_pk_bf16(v0[2], v0[3]); w.z = cvt_pk_bf16(v1[0], v1[1]); w.w = cvt_pk_bf16(v1[2], v1[3]); *(u32x4*)p = w; }
    __device__ __forceinline__ void generic(const f32x4 (&acc)[2][2][4][2], const Unit& u, int wr, int wc, int fr, int fq) const { asm volatile("" : "+v"(fr), "+v"(fq));
        const int pn = u.pn, cw = wc * 32 + 8 * fq; bf16_t* d0; bf16_t* d1; int ldc = 1024, b0, b1; bool sg = false; float sc = 1.f;
        if (pn < 4) { d0 = AQ + 256 * pn + cw; d1 = d0 + 128; b0 = 256 * pn + cw; b1 = b0 + 128; sc = C2; }
        else if (pn == 4) { ldc = 128; d0 = AK + cw; d1 = AV + cw; b0 = 1024 + cw; b1 = 1152 + cw; }
        else if (pn < 17) { const int t = pn - 13; d0 = V + 256 * t + cw; d1 = d0 + 128; b0 = 3328 + 256 * t + cw; b1 = b0 + 128; }
        else { const int t = pn - 17; d0 = SG + 256 * t + cw; d1 = d0 + 128; b0 = 4352 + 256 * t + cw; b1 = b0 + 128; sg = true; }
        const f32x4 bv00 = *(const f32x4*)(bias + b0), bv01 = *(const f32x4*)(bias + b0 + 4), bv10 = *(const f32x4*)(bias + b1), bv11 = *(const f32x4*)(bias + b1 + 4);
        const int row0 = u.pm * BM + wr * 64 + fr;
#pragma unroll
        for (int ai = 0; ai < 2; ++ai)
#pragma unroll
            for (int m = 0; m < 4; ++m) { const size_t ro = (size_t)(row0 + ai * HALF + m * 16) * ldc;
                f32x4 a0 = acc[ai][0][m][0] + bv00, a1 = acc[ai][0][m][1] + bv01, c0 = acc[ai][1][m][0] + bv10, c1 = acc[ai][1][m][1] + bv11;
                if (sg) {
#pragma unroll
                    for (int i = 0; i < 4; ++i) { a0[i] = sigm(a0[i]); a1[i] = sigm(a1[i]); c0[i] = sigm(c0[i]); c1[i] = sigm(c1[i]); } }
                else { a0 = a0 * sc; a1 = a1 * sc; c0 = c0 * sc; c1 = c1 * sc; }
                store8(d0 + ro, a0, a1); store8(d1 + ro, c0, c1); }
    }
    __device__ __forceinline__ void gates(const f32x4 (&acc)[2][2][4][2], const Unit& u, int wr, int wc, int fr, int fq) const { asm volatile("" : "+v"(fr), "+v"(fq));
        const int t = u.pn - 21, ch = 128 * t + wc * 32 + 8 * fq;
        const f32x4 ba0 = *(const f32x4*)(bias + 5376 + ch), ba1 = *(const f32x4*)(bias + 5376 + ch + 4), bb0 = *(const f32x4*)(bias + 6400 + ch), bb1 = *(const f32x4*)(bias + 6400 + ch + 4);
        const int row0 = u.pm * BM + wr * 64 + fr;
#pragma unroll
        for (int ai = 0; ai < 2; ++ai)
#pragma unroll
            for (int m = 0; m < 4; ++m) { const size_t ro = (size_t)(row0 + ai * HALF + m * 16) * 1024 + ch;
                f32x4 a0 = acc[ai][0][m][0] + ba0, a1 = acc[ai][0][m][1] + ba1, c0 = acc[ai][1][m][0] + bb0, c1 = acc[ai][1][m][1] + bb1;
#pragma unroll
                for (int i = 0; i < 4; ++i) { const float e0 = 1.f + ex2(-LOG2E * c0[i]), e1 = 1.f + ex2(-LOG2E * c1[i]);
                    a0[i] = sigm(a0[i]) * e0; a1[i] = sigm(a1[i]) * e1; c0[i] = rcp(e0); c1[i] = rcp(e1); }
                store8(SR + ro, a0, a1); store8(SB + ro, c0, c1); }
    }
    __device__ __forceinline__ void hgrn(f32x4 (&acc)[2][2][4][2], const Unit& u, int wr, int wc, int fr, int fq) const { asm volatile("" : "+v"(fr), "+v"(fq));
        const int h = u.pn - 5, ch = 128 * h + wc * 32 + 8 * fq;
        float bq[8], bf[8], lb[8], oml[8];
#pragma unroll
        for (int e = 0; e < 8; ++e) { bq[e] = bias[1280 + ch + e]; bf[e] = bias[2304 + ch + e]; lb[e] = sigm(lbl[ch + e] - lbl[1024 + ch + e]); oml[e] = 1.f - lb[e]; }
        const int row0 = u.pm * BM + wr * 64 + fr;
#pragma unroll
        for (int ai = 0; ai < 2; ++ai) {
            float carry[8], bmid[8], kk[4][8];
#pragma unroll
            for (int e = 0; e < 8; ++e) carry[e] = 0.f;
#pragma unroll
            for (int m = 0; m < 4; ++m) {
#pragma unroll
                for (int e = 0; e < 8; ++e) { const int n = e >> 2, i = e & 3;
                    const float fp = acc[ai][1][m][n][i] + bf[e], sg = sigm(fp), f = lb[e] + oml[e] * sg;
                    kk[m][e] = oml[e] * (1.f - sg);
                    float x = row16_scan(__builtin_amdgcn_logf(f)) + carry[e];
                    carry[e] = __shfl(x, 15, 16);
                    acc[ai][1][m][n][i] = x; }
                if (m == 1) {
#pragma unroll
                    for (int e = 0; e < 8; ++e) bmid[e] = carry[e]; }
            }
            const int cr = (u.pm * BM + ai * HALF + wr * 64) >> 6;
            if (fr == 15) { float* pm_ = BMID + (size_t)cr * 1024 + ch; float* pl_ = BLAST + (size_t)cr * 1024 + ch;
                *(f32x4*)pm_ = (f32x4){bmid[0], bmid[1], bmid[2], bmid[3]}; *(f32x4*)(pm_ + 4) = (f32x4){bmid[4], bmid[5], bmid[6], bmid[7]};
                *(f32x4*)pl_ = (f32x4){carry[0], carry[1], carry[2], carry[3]}; *(f32x4*)(pl_ + 4) = (f32x4){carry[4], carry[5], carry[6], carry[7]}; }
#pragma unroll
            for (int m = 0; m < 4; ++m) { const size_t ro = (size_t)(row0 + ai * HALF + m * 16) * 1024 + ch; f32x4 q0, q1, k0, k1;
#pragma unroll
                for (int e = 0; e < 8; ++e) { const int n = e >> 2, i = e & 3;
                    const float hq = acc[ai][0][m][n][i] + bq[e], eb = ex2(acc[ai][1][m][n][i] - bmid[e]);
                    const float qv = hq * sigm(hq) * eb, kv = kk[m][e] * rcp(eb);
                    if (n == 0) { q0[i] = qv; k0[i] = kv; } else { q1[i] = qv; k1[i] = kv; } }
                store8(Q1 + ro, q0, q1); store8(K1 + ro, k0, k1); }
        }
    }
    __device__ __forceinline__ void operator()(f32x4 (&acc)[2][2][4][2], const Unit& u, int wr, int wc, int fr, int fq) const { asm volatile("" : "+v"(fr), "+v"(fq));
        if (u.pn >= 5 && u.pn < 13) hgrn(acc, u, wr, wc, fr, fq);
        else if (u.pn >= 21) gates(acc, u, wr, wc, fr, fq);
        else generic(acc, u, wr, wc, fr, fq);
    }
};

struct EpiMerge {
    static constexpr bool PERM = true, AFTER_DRAIN = false;
    const bf16_t *SR, *SB; bf16_t* MG;
    __device__ __forceinline__ void scale(f32x4 (&acc)[2][2][4][2], const bf16_t* G, const Unit& u, int wr, int wc, int fr, int fq) const { asm volatile("" : "+v"(fr), "+v"(fq));
        const int col0 = u.pn * BM + wc * 32 + 8 * fq, row0 = u.pm * BM + wr * 64 + fr;
#pragma unroll
        for (int ai = 0; ai < 2; ++ai)
#pragma unroll
            for (int m = 0; m < 4; ++m)
#pragma unroll
                for (int bj = 0; bj < 2; ++bj) { const u32x4 w = *(const u32x4*)(G + (size_t)(row0 + ai * HALF + m * 16) * 1024 + col0 + bj * HALF);
                    acc[ai][bj][m][0] = acc[ai][bj][m][0] * (f32x4){bf_lo(w.x), bf_hi(w.x), bf_lo(w.y), bf_hi(w.y)};
                    acc[ai][bj][m][1] = acc[ai][bj][m][1] * (f32x4){bf_lo(w.z), bf_hi(w.z), bf_lo(w.w), bf_hi(w.w)};
                    if (bj == 1) asm volatile("" ::: "memory"); }
    }
    __device__ __forceinline__ void mid(f32x4 (&acc)[2][2][4][2], const Unit& u, int wr, int wc, int fr, int fq) const { asm volatile("" : "+v"(fr), "+v"(fq)); scale(acc, SR, u, wr, wc, fr, fq); }
    __device__ __forceinline__ void operator()(f32x4 (&acc)[2][2][4][2], const Unit& u, int wr, int wc, int fr, int fq) const { asm volatile("" : "+v"(fr), "+v"(fq));
        scale(acc, SB, u, wr, wc, fr, fq);
        const int col0 = u.pn * BM + wc * 32 + 8 * fq, row0 = u.pm * BM + wr * 64 + fr;
#pragma unroll
        for (int ai = 0; ai < 2; ++ai)
#pragma unroll
            for (int m = 0; m < 4; ++m)
#pragma unroll
                for (int bj = 0; bj < 2; ++bj) { const f32x4 v0 = acc[ai][bj][m][0], v1 = acc[ai][bj][m][1]; u32x4 w; w.x = cvt_pk_bf16(v0[0], v0[1]); w.y = cvt_pk_bf16(v0[2], v0[3]); w.z = cvt_pk_bf16(v1[0], v1[1]); w.w = cvt_pk_bf16(v1[2], v1[3]);
                    *(u32x4*)(MG + (size_t)(row0 + ai * HALF + m * 16) * 1024 + col0 + bj * HALF) = w; }
    }
};

struct EpiRes {
    static constexpr bool PERM = true, AFTER_DRAIN = false;
    const float* base; float* Hout; bf16_t* Hb; float* SSQ;
    __device__ __forceinline__ void operator()(f32x4 (&acc)[2][2][4][2], const Unit& u, int wr, int wc, int fr, int fq) const { asm volatile("" : "+v"(fr), "+v"(fq));
        const int col0 = u.pn * BM + wc * 32 + 8 * fq, row0 = u.pm * BM + wr * 64 + fr;
#pragma unroll
        for (int ai = 0; ai < 2; ++ai)
#pragma unroll
            for (int m = 0; m < 4; ++m) { const int row = row0 + ai * HALF + m * 16; const size_t ro = (size_t)row * 1024 + col0; float s = 0.f;
#pragma unroll
                for (int bj = 0; bj < 2; ++bj) { const f32x4 x0 = *(const f32x4*)(base + ro + bj * HALF), x1 = *(const f32x4*)(base + ro + bj * HALF + 4);
                    const f32x4 v0 = acc[ai][bj][m][0] + x0, v1 = acc[ai][bj][m][1] + x1;
                    *(f32x4*)(Hout + ro + bj * HALF) = v0; *(f32x4*)(Hout + ro + bj * HALF + 4) = v1;
                    if (Hb) { u32x4 w; w.x = cvt_pk_bf16(v0[0], v0[1]); w.y = cvt_pk_bf16(v0[2], v0[3]); w.z = cvt_pk_bf16(v1[0], v1[1]); w.w = cvt_pk_bf16(v1[2], v1[3]); *(u32x4*)(Hb + ro + bj * HALF) = w; }
                    s += (v0[0] * v0[0] + v0[1] * v0[1]) + (v0[2] * v0[2] + v0[3] * v0[3]) + (v1[0] * v1[0] + v1[1] * v1[1]) + (v1[2] * v1[2] + v1[3] * v1[3]); }
                s += __shfl_xor(s, 16); s += __shfl_xor(s, 32);
                if (fq == 0) SSQ[(size_t)row * 16 + 4 * u.pn + wc] = s;
                if (m & 1) asm volatile("" ::: "memory"); }
    }
};

struct EpiGU {
    static constexpr bool PERM = true, AFTER_DRAIN = false;
    const float* SSQ; bf16_t* Z;
    __device__ __forceinline__ void operator()(f32x4 (&acc)[2][2][4][2], const Unit& u, int wr, int wc, int fr, int fq) const { asm volatile("" : "+v"(fr), "+v"(fq));
        const int col0 = u.pn * 128 + wc * 32 + 8 * fq, row0 = u.pm * BM + wr * 64 + fr;
#pragma unroll
        for (int ai = 0; ai < 2; ++ai)
#pragma unroll
            for (int m = 0; m < 4; ++m) { const int row = row0 + ai * HALF + m * 16; const f32x4* sp = (const f32x4*)(SSQ + (size_t)row * 16);
                const f32x4 s0 = sp[0], s1 = sp[1], s2 = sp[2], s3 = sp[3]; const f32x4 st = (s0 + s1) + (s2 + s3);
                const float r = __builtin_amdgcn_rsqf(((st[0] + st[1]) + (st[2] + st[3])) * (1.f / 1024.f) + 1e-6f);
                f32x4 z0, z1;
#pragma unroll
                for (int i = 0; i < 4; ++i) { const float g0 = acc[ai][0][m][0][i] * r, g1 = acc[ai][0][m][1][i] * r; z0[i] = g0 * sigm(g0) * (acc[ai][1][m][0][i] * r); z1[i] = g1 * sigm(g1) * (acc[ai][1][m][1][i] * r); }
                u32x4 w; w.x = cvt_pk_bf16(z0[0], z0[1]); w.y = cvt_pk_bf16(z0[2], z0[3]); w.z = cvt_pk_bf16(z1[0], z1[1]); w.w = cvt_pk_bf16(z1[2], z1[3]);
                *(u32x4*)(Z + (size_t)row * 2816 + col0) = w; }
    }
};
template <class Epi, class Sched, bool ALIGN_EPI = false, bool SP2 = false, bool SPLIT = false>
__device__ __forceinline__ void gemm_phase(PG8_LAS unsigned char* lds, const Gemm g, const Sched& S, const Epi& E) {
    const int tid = threadIdx.x, wid = __builtin_amdgcn_readfirstlane(tid >> 6), lane = tid & 63, wr = wid >> 2, wc = wid & 3, fr = lane & 15, fq = lane >> 4;
    const int K = g.K, nt = K / BK, LD = g.ld;
    unsigned voffA[2], voffB[2];
#pragma unroll
    for (int i = 0; i < 2; ++i) { int R, C; stage_rc(tid * 16 + i * 8192, R, C); const int Rb = Epi::PERM ? ((R & ~31) + perm32(R & 31)) : R;
        voffA[i] = (unsigned)(R * LD + C) * 2u; voffB[i] = (unsigned)(Rb * LD + C) * 2u; }
    const size_t kstep = (size_t)(BK * 2);
    const size_t hstep = (size_t)HALF * LD * 2;
    const size_t tstep = 2 * hstep;
    const unsigned ldsw = (unsigned)wid * 1024u;
    const int aoff = lds_byte(wr * 64 + fr, fq * 8), boff = lds_byte(wc * 32 + fr, fq * 8);
#define PG8_SA(b, h) (((b) * 2 + (h)) * HTB)
#define PG8_SB(b, h) ((4 + (b) * 2 + (h)) * HTB)
#define PG8_STAGE(bufoff, gbase, voff) do { _Pragma("unroll") for (int _i = 0; _i < 2; ++_i) \
        __builtin_amdgcn_global_load_lds((const unsigned*)((const char*)(gbase) + (voff)[_i]), (PG8_LAS unsigned*)(lds + (bufoff) + ldsw + _i * 8192), 16, 0, 0); } while (0)
#define PG8_LDA(dst, b, h) do { _Pragma("unroll") for (int m = 0; m < 4; ++m) _Pragma("unroll") for (int k = 0; k < 2; ++k) dst[m][k] = *(const PG8_LAS bf16x8*)(lds + PG8_SA(b, h) + aoff + m * 2048 + k * 1024); } while (0)
#define PG8_LDB(dst, b, h) do { _Pragma("unroll") for (int n = 0; n < 2; ++n) _Pragma("unroll") for (int k = 0; k < 2; ++k) dst[n][k] = *(const PG8_LAS bf16x8*)(lds + PG8_SB(b, h) + boff + n * 2048 + k * 1024); } while (0)
#define PG8_MMA(ai, bj, At, Bt) do { __builtin_amdgcn_s_setprio(1); _Pragma("unroll") for (int m = 0; m < 4; ++m) _Pragma("unroll") for (int n = 0; n < 2; ++n) _Pragma("unroll") for (int k = 0; k < 2; ++k) \
        acc[ai][bj][m][n] = __builtin_amdgcn_mfma_f32_16x16x32_bf16(Bt[n][k], At[m][k], acc[ai][bj][m][n], 0, 0, 0); __builtin_amdgcn_s_setprio(0); } while (0)
#define PG8_WAIT_V(n) asm volatile("s_waitcnt vmcnt(" #n ")" ::: "memory")
#define PG8_WAIT_L(n) asm volatile("s_waitcnt lgkmcnt(" #n ")" ::: "memory")
#define PG8_BAR __builtin_amdgcn_s_barrier()
#define PG8_SCHED __builtin_amdgcn_sched_barrier(0)
    Unit cur, nxt; int ui = 0;
    if (!S.next(0, cur)) return;
    f32x4 acc[2][2][4][2];
#pragma unroll
    for (int a = 0; a < 2; ++a)
#pragma unroll
        for (int b = 0; b < 2; ++b)
#pragma unroll
            for (int m = 0; m < 4; ++m)
#pragma unroll
                for (int n = 0; n < 2; ++n) acc[a][b][m][n] = (f32x4){0.f, 0.f, 0.f, 0.f};
    bf16x8 At[4][2], B0[2][2], B1[2][2];
    const char* cA = (const char*)g.A + (size_t)cur.pm * tstep; const char* cB = (const char*)g.Bt + (size_t)cur.pn * tstep;
    const char* cA2 = cA; const char* cB2 = cB;
    if constexpr (SPLIT) { cA2 = (const char*)g.A2 + (size_t)cur.pm * tstep - (size_t)g.ks * kstep; cB2 = (const char*)g.Bt2 + (size_t)cur.pn * tstep - (size_t)g.ks * kstep; }
    S.a_ready(cur);
    if constexpr (SP2) {
        PG8_STAGE(PG8_SB(0, 0), cB, voffB); PG8_STAGE(PG8_SB(0, 1), cB + hstep, voffB); PG8_STAGE(PG8_SA(0, 0), cA, voffA); PG8_STAGE(PG8_SA(0, 1), cA + hstep, voffA);
        if (wr == 1) PG8_BAR;
        PG8_WAIT_V(2); PG8_BAR;
        PG8_STAGE(PG8_SB(1, 0), cB + kstep, voffB); PG8_STAGE(PG8_SA(1, 0), cA + kstep, voffA); PG8_STAGE(PG8_SB(1, 1), cB + hstep + kstep, voffB);
        PG8_WAIT_V(6); PG8_BAR;
    } else {
        PG8_STAGE(PG8_SB(0, 0), cB, voffB); PG8_STAGE(PG8_SA(0, 0), cA, voffA); PG8_STAGE(PG8_SB(0, 1), cB + hstep, voffB); PG8_STAGE(PG8_SA(0, 1), cA + hstep, voffA);
        if (wr == 1) PG8_BAR;
        PG8_WAIT_V(4); PG8_BAR;
        PG8_STAGE(PG8_SB(1, 0), cB + kstep, voffB); PG8_STAGE(PG8_SA(1, 0), cA + kstep, voffA); PG8_STAGE(PG8_SB(1, 1), cB + hstep + kstep, voffB);
        PG8_WAIT_V(6); PG8_BAR;
    }
    for (;;) {
        const bool has_next = S.next(ui + 1, nxt);
        const char* nA = has_next ? (const char*)g.A + (size_t)nxt.pm * tstep : cA; const char* nB = has_next ? (const char*)g.Bt + (size_t)nxt.pn * tstep : cB;
        for (int t = 0; t < nt; t += 2) {
            const bool last = (t == nt - 2);
            const char* sA = cA; const char* sA2 = cA; const char* sB2 = cB;
            if constexpr (SPLIT) { if (t >= g.ks) sA = cA2; if (t + 2 >= g.ks) { sA2 = cA2; sB2 = cB2; } if (t == g.ks) E.mid(acc, cur, wr, wc, fr, fq); }
            const char* a1 = sA + (size_t)(t + 1) * kstep;
            const char* a2 = last ? nA : sA2 + (size_t)(t + 2) * kstep; const char* b2 = last ? nB : sB2 + (size_t)(t + 2) * kstep;
            const char* a3 = a2 + kstep; const char* b3 = b2 + kstep;
            if (last && has_next) S.a_ready(nxt);
            if constexpr (SP2) {
            PG8_LDB(B0, 0, 0); PG8_LDB(B1, 0, 1); PG8_SCHED; PG8_LDA(At, 0, 0); PG8_STAGE(PG8_SA(1, 1), a1 + hstep, voffA);
            PG8_WAIT_V(8); PG8_WAIT_L(0); PG8_BAR; PG8_MMA(0, 0, At, B0); PG8_MMA(0, 1, At, B1); PG8_BAR; PG8_SCHED;
            PG8_LDA(At, 0, 1); PG8_STAGE(PG8_SB(0, 0), b2, voffB); PG8_STAGE(PG8_SB(0, 1), b2 + hstep, voffB); PG8_STAGE(PG8_SA(0, 0), a2, voffA);
            PG8_WAIT_V(8); PG8_WAIT_L(0); PG8_BAR; PG8_MMA(1, 0, At, B0); PG8_MMA(1, 1, At, B1); PG8_BAR; PG8_SCHED;
            PG8_LDB(B0, 1, 0); PG8_LDB(B1, 1, 1); PG8_SCHED; PG8_LDA(At, 1, 0); PG8_STAGE(PG8_SA(0, 1), a2 + hstep, voffA);
            PG8_WAIT_V(8); PG8_WAIT_L(0); PG8_BAR; PG8_MMA(0, 0, At, B0); PG8_MMA(0, 1, At, B1); PG8_BAR; PG8_SCHED;
            PG8_LDA(At, 1, 1); PG8_STAGE(PG8_SB(1, 0), b3, voffB); PG8_STAGE(PG8_SB(1, 1), b3 + hstep, voffB); PG8_STAGE(PG8_SA(1, 0), a3, voffA);
            PG8_WAIT_V(8); PG8_WAIT_L(0); PG8_BAR; PG8_MMA(1, 0, At, B0); PG8_MMA(1, 1, At, B1); PG8_BAR; PG8_SCHED;
            } else {
            PG8_LDB(B0, 0, 0); PG8_SCHED; PG8_LDA(At, 0, 0); PG8_STAGE(PG8_SA(1, 1), a1 + hstep, voffA);
            PG8_WAIT_L(8); PG8_BAR; PG8_WAIT_L(0); PG8_MMA(0, 0, At, B0); PG8_BAR; PG8_SCHED;
            PG8_LDB(B1, 0, 1); PG8_STAGE(PG8_SB(0, 0), b2, voffB);
            PG8_BAR; PG8_WAIT_L(0); PG8_MMA(0, 1, At, B1); PG8_BAR;
            PG8_LDA(At, 0, 1); PG8_STAGE(PG8_SA(0, 0), a2, voffA);
            PG8_BAR; PG8_WAIT_L(0); PG8_MMA(1, 0, At, B0); PG8_BAR; PG8_SCHED;
            PG8_STAGE(PG8_SB(0, 1), b2 + hstep, voffB);
            PG8_WAIT_V(6); PG8_BAR; PG8_MMA(1, 1, At, B1); PG8_BAR;
            PG8_LDB(B0, 1, 0); PG8_SCHED; PG8_LDA(At, 1, 0); PG8_STAGE(PG8_SA(0, 1), a2 + hstep, voffA);
            PG8_WAIT_L(8); PG8_BAR; PG8_WAIT_L(0); PG8_MMA(0, 0, At, B0); PG8_BAR; PG8_SCHED;
            PG8_LDB(B1, 1, 1); PG8_STAGE(PG8_SB(1, 0), b3, voffB);
            PG8_BAR; PG8_WAIT_L(0); PG8_MMA(0, 1, At, B1); PG8_BAR;
            PG8_LDA(At, 1, 1); PG8_STAGE(PG8_SA(1, 0), a3, voffA);
            PG8_BAR; PG8_WAIT_L(0); PG8_MMA(1, 0, At, B0); PG8_BAR; PG8_SCHED;
            PG8_STAGE(PG8_SB(1, 1), b3 + hstep, voffB);
            PG8_WAIT_V(6); PG8_BAR; PG8_MMA(1, 1, At, B1); PG8_BAR;
            }
        }
        if constexpr (ALIGN_EPI) { if (wr == 0) PG8_BAR; }
        if constexpr (!Epi::AFTER_DRAIN) { E(acc, cur, wr, wc, fr, fq); S.done(cur); }
        if (!has_next) break;
#pragma unroll
        for (int a = 0; a < 2; ++a)
#pragma unroll
            for (int b = 0; b < 2; ++b)
#pragma unroll
                for (int m = 0; m < 4; ++m)
#pragma unroll
                    for (int n = 0; n < 2; ++n) acc[a][b][m][n] = (f32x4){0.f, 0.f, 0.f, 0.f};
        cur = nxt; cA = nA; cB = nB; ++ui;
        if constexpr (SPLIT) { cA2 = (const char*)g.A2 + (size_t)cur.pm * tstep - (size_t)g.ks * kstep; cB2 = (const char*)g.Bt2 + (size_t)cur.pn * tstep - (size_t)g.ks * kstep; }
        if constexpr (ALIGN_EPI) { if (wr == 1) PG8_BAR; }
    }
    PG8_WAIT_V(0);
    if constexpr (!ALIGN_EPI) { if (wr == 0) PG8_BAR; }
    PG8_BAR;
    if constexpr (Epi::AFTER_DRAIN) { E.fused(acc, cur, wr, wc, fr, fq, lds, wid, lane); S.done(cur); }
#undef PG8_SA
#undef PG8_SB
#undef PG8_STAGE
#undef PG8_LDA
#undef PG8_LDB
#undef PG8_MMA
#undef PG8_WAIT_V
#undef PG8_WAIT_L
#undef PG8_BAR
#undef PG8_SCHED
}
}
#define GAS __attribute__((address_space(1)))
#define LAS __attribute__((address_space(3)))
typedef unsigned short bf16;
typedef unsigned v4u __attribute__((ext_vector_type(4)));
typedef float f32x4 __attribute__((ext_vector_type(4)));
typedef short bf16x8 __attribute__((ext_vector_type(8)));
typedef GAS unsigned gu32;
typedef GAS unsigned long long gu64;
#define RLX_AGENT __ATOMIC_RELAXED, __HIP_MEMORY_SCOPE_AGENT
#define LDS_WAIT() asm volatile("s_waitcnt lgkmcnt(0)" ::: "memory")
#define VM_WAIT() asm volatile("s_waitcnt vmcnt(0)" ::: "memory")
__device__ __forceinline__ unsigned long long rt() { return __builtin_amdgcn_s_memrealtime(); }
__device__ __forceinline__ unsigned f2bf(float f) { unsigned u = __builtin_bit_cast(unsigned, f); return (u + 0x7fffu + ((u >> 16) & 1u)) >> 16; }
__device__ __forceinline__ unsigned pk2(float lo, float hi) { return f2bf(lo) | (f2bf(hi) << 16); }

#define XB_TMO      128
#define XB_XCNT(j)  (256  + 64 * (j))
#define XB_XSUB(j)  (1280 + 64 * (j))
#define XB_XGEN(j)  (2304 + 64 * (j))
#define XB_TOP      3328
#define XB_TOPGEN   3392
#define XCD_BAR_WORDS 3456
#define XB_SPIN_CAP (1u << 18)

__device__ __forceinline__ unsigned xb_ld(unsigned* p)              { return __hip_atomic_load(p, __ATOMIC_RELAXED, __HIP_MEMORY_SCOPE_AGENT); }
__device__ __forceinline__ unsigned xb_add(unsigned* p, unsigned v) { return __hip_atomic_fetch_add(p, v, __ATOMIC_RELAXED, __HIP_MEMORY_SCOPE_AGENT); }
__device__ __forceinline__ unsigned xb_xcc_id() { return (unsigned)__builtin_amdgcn_s_getreg((3 << 11) | 20) & 0xFu; }
#define XB_SPIN(cond, bar) do { unsigned _sp = 0; while (cond) { __builtin_amdgcn_s_sleep(1); \
    if ((++_sp & 255u) == 0u) { if (xb_ld(&(bar)[XB_TMO])) break; if (_sp > XB_SPIN_CAP) { atomicAdd(&(bar)[XB_TMO], 1u); break; } } } } while (0)

struct XcdBarrier {
    unsigned* bar; unsigned x;
    volatile LAS unsigned* st;
};

__device__ __forceinline__ XcdBarrier xcd_barrier_post(unsigned* bar, volatile LAS unsigned* st) {
    XcdBarrier b; b.bar = bar; b.x = xb_xcc_id(); b.st = st;
    if (threadIdx.x == 0) (void)xb_add(&bar[XB_XCNT(b.x)], 1u);
    return b;
}
__device__ __forceinline__ void xcd_barrier_complete(unsigned* bar, unsigned x, unsigned& nloc, unsigned& nx) {
    const unsigned G = gridDim.x * gridDim.y * gridDim.z;
    unsigned sum, cnt, mine, sp = 0u;
    for (;;) {
        sum = 0u; cnt = 0u; mine = 0u;
#pragma unroll
        for (unsigned j = 0; j < 16; ++j) { const unsigned c = xb_ld(&bar[XB_XCNT(j)]); sum += c; cnt += (c > 0u) ? 1u : 0u; mine = (j == x) ? c : mine; }
        if (sum == G) break;
        __builtin_amdgcn_s_sleep(1);
        if ((++sp & 255u) == 0u) { if (xb_ld(&bar[XB_TMO])) break; if (sp > XB_SPIN_CAP) { atomicAdd(&bar[XB_TMO], 1u); break; } }
    }
    nloc = mine > 0u ? mine : 1u; nx = cnt > 0u ? cnt : 1u;
}

__device__ __forceinline__ void xcd_barrier(const XcdBarrier& b) {
    asm volatile("s_waitcnt vmcnt(0)" ::: "memory");
    __syncthreads();
    if (threadIdx.x == 0) {
        unsigned* bar = b.bar;
        __builtin_amdgcn_s_waitcnt(0);
        unsigned nloc = b.st[0], nx = b.st[1];
        if (nloc == 0u) { xcd_barrier_complete(bar, b.x, nloc, nx); b.st[0] = nloc; b.st[1] = nx; }
        const unsigned old = xb_add(&bar[XB_XSUB(b.x)], 1u);
        const unsigned gen = old / nloc;
        if (old + 1u == (gen + 1u) * nloc) {
            __builtin_amdgcn_fence(__ATOMIC_RELEASE, "agent");
            asm volatile("s_waitcnt vmcnt(0)" ::: "memory");
            const unsigned og = xb_add(&bar[XB_TOP], 1u);
            const unsigned tg = og / nx;
            if (og + 1u == (tg + 1u) * nx) xb_add(&bar[XB_TOPGEN], 1u);
            else XB_SPIN(xb_ld(&bar[XB_TOPGEN]) == tg, bar);
            __builtin_amdgcn_fence(__ATOMIC_ACQUIRE, "agent");
            xb_add(&bar[XB_XGEN(b.x)], 1u);
            asm volatile("s_waitcnt vmcnt(0)" ::: "memory");
        } else {
            XB_SPIN(xb_ld(&bar[XB_XGEN(b.x)]) == gen, bar);
            __builtin_amdgcn_fence(__ATOMIC_ACQUIRE, "agent");
            asm volatile("s_waitcnt vmcnt(0)" ::: "memory");
        }
    }
    __syncthreads();
}

constexpr int NWAVES = 8;
constexpr int BATCH = 4, SEQ = 4096, D = 1024, M = BATCH * SEQ, INW = 7424, FF = 2816, NH = 8;
constexpr float EPS = 1e-6f;
constexpr size_t MiB = 1u << 20;
constexpr size_t WS_CTL = 0, CTL_ZERO_BYTES = 1 * MiB;
constexpr size_t WS_BM = 1 * MiB, WS_BL = 2 * MiB, WS_SSQ = 3 * MiB, WS_SSQ2 = 4 * MiB;
constexpr size_t WS_WIN = 5 * MiB, WS_WBA = 20 * MiB, WS_WBH = 22 * MiB, WS_WOUT = 24 * MiB, WS_WGU = 26 * MiB, WS_WD = 37 * MiB;
constexpr size_t WS_XN = 43 * MiB;
constexpr size_t WS_L = WS_XN;
constexpr size_t WS_AQ = 75 * MiB, WS_AK = 107 * MiB, WS_AV = 111 * MiB, WS_Q1 = 115 * MiB, WS_K1 = 147 * MiB, WS_V = 179 * MiB, WS_SG = 211 * MiB, WS_END = 243 * MiB;
constexpr size_t WS_MG = WS_K1;
constexpr size_t WS_Z = WS_AQ;
static_assert(WS_WIN + (size_t)INW * D * 2 <= WS_WBA && WS_WGU + (size_t)2 * FF * D * 2 <= WS_WD && WS_WD + (size_t)D * FF * 2 <= WS_XN, "weight map");
static_assert(WS_Z + (size_t)M * FF * 2 <= WS_END, "z overlay");
constexpr int CW_TMO = 0, CW_BAR = 4096;

constexpr int RING_OFF = 0, RING_BYTES = 131072;
constexpr int LDSCTL_OFF = RING_BYTES, MISC_OFF = LDSCTL_OFF + 320;
constexpr int LDS_BYTES = 147456;

struct Frame {
    LAS unsigned char* lds;
    volatile LAS unsigned* MISC;
    gu32* ctl;
    int tid, lane, wave, vcu, G;
};

__device__ __forceinline__ int fresh_tid() { int t = threadIdx.x; asm volatile("" : "+v"(t)); return t; }
__device__ __forceinline__ float wave_sum(float v) {
#pragma unroll
    for (int o = 1; o < 64; o <<= 1) v += __shfl_xor(v, o);
    return v;
}
__device__ __forceinline__ void p0_transpose_item(const float* W, int K, int N, bf16* WT, int k0, int src_col0, int dst_row0, const float* gk, LAS float* scr, int lane) {
#pragma unroll 8
    for (int i = 0; i < 32; ++i) { const int kk = 2 * i + (lane >> 5); float w = W[(size_t)(k0 + kk) * N + src_col0 + (lane & 31)]; if (gk) w *= gk[k0 + kk]; scr[kk * 33 + (lane & 31)] = w; }
    LDS_WAIT(); asm volatile("" ::: "memory");
    const int c = lane & 7;
#pragma unroll
    for (int j = 0; j < 4; ++j) { const int n = (lane >> 3) + 8 * j; const LAS float* s = scr + (8 * c) * 33 + n;
        v4u o; o.x = pk2(s[0 * 33], s[1 * 33]); o.y = pk2(s[2 * 33], s[3 * 33]); o.z = pk2(s[4 * 33], s[5 * 33]); o.w = pk2(s[6 * 33], s[7 * 33]);
        *(GAS v4u*)(WT + (size_t)(dst_row0 + n) * K + k0 + 8 * c) = o; }
    LDS_WAIT(); asm volatile("" ::: "memory");
}
__device__ __forceinline__ int in_src_col(int vc) {
    if (vc >= 1280 && vc < 3328) { const int r = vc - 1280; return ((r >> 7) & 1 ? 2304 : 1280) + 128 * (r >> 8) + (r & 127); }
    if (vc >= 5376) { const int r = vc - 5376; return ((r >> 7) & 1 ? 6400 : 5376) + 128 * (r >> 8) + (r & 127); }
    return vc;
}
struct P0Args { const float *x, *g_mix, *w_in, *wba, *wbh, *wout, *g_ffn, *wg, *wu, *wd; bf16 *Win_t, *Wba_t, *Wbh_t, *Wout_t, *Wgu_t, *Wd_t, *XN; };
__device__ __forceinline__ void p0_prologue(Frame& F, const P0Args& a) {
    LAS float* scr = (LAS float*)(F.lds + RING_OFF + F.wave * 16384);
    const int gw = F.vcu * NWAVES + F.wave, NGW = F.G * NWAVES, lane_ = fresh_tid() & 63;
    constexpr int I_IN = (D / 64) * (INW / 32), I_SQ = (D / 64) * (D / 32), I_GU = (D / 64) * (2 * FF / 32), I_D = (FF / 64) * (D / 32);
    constexpr int NITEMS = I_IN + 3 * I_SQ + I_GU + I_D;
    for (int it = gw; it < NITEMS; it += NGW) {
        int r = it;
        if (r < I_IN) { const int nblk = INW / 32, kb = r / nblk, nb = r % nblk; p0_transpose_item(a.w_in, D, INW, a.Win_t, 64 * kb, in_src_col(32 * nb), 32 * nb, nullptr, scr, lane_); continue; } r -= I_IN;
        if (r < I_SQ) { const int nblk = D / 32, kb = r / nblk, nb = r % nblk; p0_transpose_item(a.wba, D, D, a.Wba_t, 64 * kb, 32 * nb, 32 * nb, nullptr, scr, lane_); continue; } r -= I_SQ;
        if (r < I_SQ) { const int nblk = D / 32, kb = r / nblk, nb = r % nblk; p0_transpose_item(a.wbh, D, D, a.Wbh_t, 64 * kb, 32 * nb, 32 * nb, nullptr, scr, lane_); continue; } r -= I_SQ;
        if (r < I_SQ) { const int nblk = D / 32, kb = r / nblk, nb = r % nblk; p0_transpose_item(a.wout, D, D, a.Wout_t, 64 * kb, 32 * nb, 32 * nb, nullptr, scr, lane_); continue; } r -= I_SQ;
        if (r < I_GU) { const int nblk = 2 * FF / 32, kb = r / nblk, nb = r % nblk, vc = 32 * nb, t = vc >> 8, j = (vc >> 7) & 1, i = vc & 127;
            if (j) p0_transpose_item(a.wu, D, FF, a.Wgu_t, 64 * kb, 128 * t + i, vc, a.g_ffn, scr, lane_); else p0_transpose_item(a.wg, D, FF, a.Wgu_t, 64 * kb, 128 * t + i, vc, a.g_ffn, scr, lane_);
            continue; } r -= I_GU;
        { const int nblk = D / 32, kb = r / nblk, nb = r % nblk; p0_transpose_item(a.wd, FF, D, a.Wd_t, 64 * kb, 32 * nb, 32 * nb, nullptr, scr, lane_); }
    }
    for (int m = gw; m < M; m += NGW) {
        const GAS f32x4* xr = (const GAS f32x4*)(a.x + (size_t)m * D) + lane_; const GAS f32x4* gr = (const GAS f32x4*)a.g_mix + lane_;
        f32x4 v[4]; float s = 0.f;
#pragma unroll
        for (int j = 0; j < 4; ++j) { v[j] = xr[64 * j]; s += (v[j].x * v[j].x + v[j].y * v[j].y) + (v[j].z * v[j].z + v[j].w * v[j].w); }
        const float rstd = 1.f / sqrtf(wave_sum(s) * (1.f / D) + EPS);
        GAS unsigned long long* o8 = (GAS unsigned long long*)(a.XN + (size_t)m * D) + lane_;
#pragma unroll
        for (int j = 0; j < 4; ++j) { const f32x4 g = gr[64 * j]; o8[64 * j] = (unsigned long long)pk2(v[j].x * rstd * g.x, v[j].y * rstd * g.y) | ((unsigned long long)pk2(v[j].z * rstd * g.z, v[j].w * rstd * g.w) << 32); }
    }
}
__device__ __forceinline__ float bf2f(bf16 v) { return __builtin_bit_cast(float, (unsigned)v << 16); }

__device__ __forceinline__ void attn_naive(Frame& F, bf16* AQ, const bf16* AK, const bf16* AV, const float* sinks) {
    const int gw = F.vcu * NWAVES + F.wave, NGW = F.G * NWAVES, d = fresh_tid() & 63;
    for (int w = gw; w < M * 16; w += NGW) {
        const int hq = w & 15, tok = w >> 4, hkv = hq >> 3, b = tok >> 12, i = tok & 4095;
        const float q = bf2f(AQ[(size_t)tok * D + hq * 64 + d]);
        const int j0 = i - 127 < 0 ? 0 : i - 127;
        float m = sinks[hq] * pg8::LOG2E, l = 1.f, o = 0.f;
        for (int j = j0; j <= i; ++j) { const size_t kr = (size_t)(b * SEQ + j) * 128 + hkv * 64 + d;
            float s = wave_sum(q * bf2f(AK[kr]));
            const float mn = fmaxf(m, s), al = pg8::ex2(m - mn), e = pg8::ex2(s - mn);
            l = l * al + e; o = o * al + e * bf2f(AV[kr]); m = mn; }
        AQ[(size_t)tok * D + hq * 64 + d] = (bf16)pk2(o / l, 0.f);
    }
}
__device__ __forceinline__ void hgrn_naive(Frame& F, int unit, const bf16* Q1, const bf16* K1, const bf16* V, bf16* SG, const float* BMID, const float* BLAST, const float* ng) {
    const int b = unit >> 3, h = unit & 7, tid = fresh_tid();
    LAS float* Sst = (LAS float*)(F.lds);
    LAS bf16* Qs = (LAS bf16*)(F.lds + 65536);
    LAS bf16* Ks = (LAS bf16*)(F.lds + 81920);
    LAS bf16* Vs = (LAS bf16*)(F.lds + 98304);
    LAS float* As = (LAS float*)(F.lds + 114688);
    for (int i = tid; i < 128 * 128; i += 512) Sst[i] = 0.f;
    __syncthreads();
    for (int c = 0; c < 64; ++c) {
        const size_t row0 = (size_t)b * SEQ + c * 64; const int cr = b * 64 + c;
        for (int i = tid; i < 64 * 16; i += 512) { const int r = i >> 4, ch = i & 15; const size_t go = (row0 + r) * D + h * 128 + ch * 8;
            *(LAS v4u*)(Qs + r * 128 + ch * 8) = *(const v4u*)(Q1 + go); *(LAS v4u*)(Ks + r * 128 + ch * 8) = *(const v4u*)(K1 + go); *(LAS v4u*)(Vs + r * 128 + ch * 8) = *(const v4u*)(V + go); }
        __syncthreads();
        { const int cc = tid >> 3, sg = tid & 7;
#pragma unroll
            for (int u = 0; u < 8; ++u) { const int s = sg * 8 + u; float a = 0.f;
                if (s <= cc) for (int k = 0; k < 128; ++k) a += bf2f(Qs[cc * 128 + k]) * bf2f(Ks[s * 128 + k]);
                As[cc * 64 + s] = a; } }
        __syncthreads();
        { const int cc = tid >> 3, v0 = (tid & 7) * 16; float o[16];
#pragma unroll
            for (int j = 0; j < 16; ++j) o[j] = 0.f;
            for (int s = 0; s <= cc; ++s) { const float a = As[cc * 64 + s];
#pragma unroll
                for (int j = 0; j < 16; ++j) o[j] += a * bf2f(Vs[s * 128 + v0 + j]); }
            for (int k = 0; k < 128; ++k) { const float qk = bf2f(Qs[cc * 128 + k]) * pg8::ex2(BMID[(size_t)cr * 1024 + h * 128 + k]);
#pragma unroll
                for (int j = 0; j < 16; ++j) o[j] += qk * Sst[k * 128 + v0 + j]; }
            float ss = 0.f;
#pragma unroll
            for (int j = 0; j < 16; ++j) ss += o[j] * o[j];
            ss += __shfl_xor(ss, 1); ss += __shfl_xor(ss, 2); ss += __shfl_xor(ss, 4);
            const float r = 1.f / sqrtf(ss * (1.f / 128.f) + EPS);
            bf16* gp = SG + (row0 + cc) * D + h * 128 + v0;
#pragma unroll
            for (int j = 0; j < 16; ++j) gp[j] = (bf16)pk2(o[j] * r * ng[h * 128 + v0 + j] * bf2f(gp[j]), 0.f); }
        __syncthreads();
        { const int k = tid >> 2, v0 = (tid & 3) * 32; float acc[32];
#pragma unroll
            for (int j = 0; j < 32; ++j) acc[j] = 0.f;
            for (int s = 0; s < 64; ++s) { const float kv = bf2f(Ks[s * 128 + k]);
#pragma unroll
                for (int j = 0; j < 32; ++j) acc[j] += kv * bf2f(Vs[s * 128 + v0 + j]); }
            const float bmv = BMID[(size_t)cr * 1024 + h * 128 + k], blv = BLAST[(size_t)cr * 1024 + h * 128 + k]; const float e1 = pg8::ex2(blv), e2 = pg8::ex2(blv - bmv);
#pragma unroll
            for (int j = 0; j < 32; ++j) Sst[k * 128 + v0 + j] = e1 * Sst[k * 128 + v0 + j] + e2 * acc[j]; }
        __syncthreads();
    }
}
__device__ __forceinline__ void final_norm(Frame& F, float* out, const float* SSQ2, const float* g_fin) {
    const int gw = F.vcu * NWAVES + F.wave, NGW = F.G * NWAVES, lane_ = fresh_tid() & 63;
    for (int m = gw; m < M; m += NGW) {
        const float p = lane_ < 16 ? SSQ2[(size_t)m * 16 + lane_] : 0.f; const float r = 1.f / sqrtf(wave_sum(p) * (1.f / D) + EPS);
        GAS f32x4* xr = (GAS f32x4*)(out + (size_t)m * D) + lane_; const GAS f32x4* gr = (const GAS f32x4*)g_fin + lane_;
#pragma unroll
        for (int j = 0; j < 4; ++j) { const f32x4 v = xr[64 * j], g = gr[64 * j]; xr[64 * j] = v * r * g; }
    }
}

struct Args { const float* in[15]; float* out; unsigned char* ws; int ph_lo, ph_hi; };
static_assert(sizeof(Args) == 15 * 8 + 8 + 8 + 8, "Args has no padding");
constexpr int N_PHASES = 8;

__global__ void __launch_bounds__(NWAVES * 64, 2) mk_fwd(Args args) {
    extern __shared__ __attribute__((aligned(16))) unsigned char lds[];
    Frame F;
    F.lds = (LAS unsigned char*)lds;
    F.MISC = (volatile LAS unsigned*)(F.lds + MISC_OFF);
    F.tid = threadIdx.x; F.lane = F.tid & 63; F.wave = __builtin_amdgcn_readfirstlane(F.tid >> 6);
    F.G = gridDim.x; { const int bx = blockIdx.x; F.vcu = (F.G % 8 == 0) ? (bx % 8) * (F.G / 8) + bx / 8 : bx; }
    unsigned char* ws = args.ws;
    F.ctl = (gu32*)(ws + WS_CTL);
    for (int u = F.tid; u < (LDS_BYTES - LDSCTL_OFF) / 4; u += NWAVES * 64) ((LAS unsigned*)(F.lds + LDSCTL_OFF))[u] = 0u;
    __syncthreads();
    const int lo = args.ph_lo, hi = args.ph_hi;
    XcdBarrier bar; bar.bar = (unsigned*)(F.ctl + CW_BAR); bar.x = 0; bar.st = nullptr;
    if (hi - lo > 1) bar = xcd_barrier_post((unsigned*)(F.ctl + CW_BAR), F.MISC + 8);
#define IN(k) (lo <= (k) && (k) < hi)
#define SEAM(k) do { if (IN(k) && IN((k) + 1)) xcd_barrier(bar); } while (0)
    const float* x = args.in[0]; const float* b_in = args.in[3]; const float* sinks = args.in[4]; const float* lbl = args.in[5]; const float* ng = args.in[6]; const float* g_fin = args.in[14];
    float* out = args.out;
    bf16* Win_t = (bf16*)(ws + WS_WIN); bf16* Wba_t = (bf16*)(ws + WS_WBA); bf16* Wbh_t = (bf16*)(ws + WS_WBH); bf16* Wout_t = (bf16*)(ws + WS_WOUT); bf16* Wgu_t = (bf16*)(ws + WS_WGU); bf16* Wd_t = (bf16*)(ws + WS_WD);
    bf16* XN = (bf16*)(ws + WS_XN); bf16* AQ = (bf16*)(ws + WS_AQ); bf16* AK = (bf16*)(ws + WS_AK); bf16* AV = (bf16*)(ws + WS_AV); bf16* Q1 = (bf16*)(ws + WS_Q1); bf16* K1 = (bf16*)(ws + WS_K1);
    bf16* V = (bf16*)(ws + WS_V); bf16* SG = (bf16*)(ws + WS_SG); bf16* MG = (bf16*)(ws + WS_MG); bf16* Z = (bf16*)(ws + WS_Z);
    bf16* SR = (bf16*)out; bf16* SB = SR + (size_t)M * D;
    float* BMID = (float*)(ws + WS_BM); float* BLAST = (float*)(ws + WS_BL); float* SSQ = (float*)(ws + WS_SSQ); float* SSQ2 = (float*)(ws + WS_SSQ2);

    if (IN(0)) { P0Args a{x, args.in[1], args.in[2], args.in[7], args.in[8], args.in[9], args.in[10], args.in[11], args.in[12], args.in[13], Win_t, Wba_t, Wbh_t, Wout_t, Wgu_t, Wd_t, XN}; p0_prologue(F, a); }
    SEAM(0);
    if (IN(1)) {
        pg8::Gemm g{XN, Win_t, M, INW, D, D, nullptr, nullptr, 0}; pg8::StaticOrder S; S.init(M, INW, F.G, (int)blockIdx.x);
        pg8::EpiIn E{AQ, AK, AV, Q1, K1, V, SG, SR, SB, BMID, BLAST, b_in, lbl};
        pg8::gemm_phase<pg8::EpiIn, pg8::StaticOrder, true, true, false>(F.lds + RING_OFF, g, S, E);
    }
    SEAM(1);
    if (IN(2)) {
        attn_naive(F, AQ, AK, AV, sinks);
        if (blockIdx.x < 32) hgrn_naive(F, (int)blockIdx.x, Q1, K1, V, SG, BMID, BLAST, ng);
    }
    SEAM(2);
    if (IN(3)) {
        pg8::Gemm g{AQ, Wba_t, M, D, 2 * D, D, SG, Wbh_t, D / 64}; pg8::StaticOrder S; S.init(M, D, F.G, (int)blockIdx.x);
        pg8::EpiMerge E{SR, SB, MG};
        pg8::gemm_phase<pg8::EpiMerge, pg8::StaticOrder, false, true, true>(F.lds + RING_OFF, g, S, E);
    }
    SEAM(3);
    if (IN(4)) {
        pg8::Gemm g{MG, Wout_t, M, D, D, D, nullptr, nullptr, 0}; pg8::StaticOrder S; S.init(M, D, F.G, (int)blockIdx.x);
        pg8::EpiRes E{x, out, XN, SSQ};
        pg8::gemm_phase<pg8::EpiRes, pg8::StaticOrder, false, true, false>(F.lds + RING_OFF, g, S, E);
    }
    SEAM(4);
    if (IN(5)) {
        pg8::Gemm g{XN, Wgu_t, M, 2 * FF, D, D, nullptr, nullptr, 0}; pg8::StaticOrder S; S.init(M, 2 * FF, F.G, (int)blockIdx.x);
        pg8::EpiGU E{SSQ, Z};
        pg8::gemm_phase<pg8::EpiGU, pg8::StaticOrder, true, true, false>(F.lds + RING_OFF, g, S, E);
    }
    SEAM(5);
    if (IN(6)) {
        pg8::Gemm g{Z, Wd_t, M, D, FF, FF, nullptr, nullptr, 0}; pg8::StaticOrder S; S.init(M, D, F.G, (int)blockIdx.x);
        pg8::EpiRes E{out, out, nullptr, SSQ2};
        pg8::gemm_phase<pg8::EpiRes, pg8::StaticOrder, false, true, false>(F.lds + RING_OFF, g, S, E);
    }
    SEAM(6);
    if (IN(7)) final_norm(F, out, SSQ2, g_fin);
#undef IN
#undef SEAM
}


#if defined(MK_DEBUG)
namespace dbg {
constexpr size_t WS_FLAGS = 244 * MiB, WS_EXP_ATT = 245 * MiB, WS_PSM = 246 * MiB;
constexpr int NS_ATT = 2048, HG_TOK = 1024, NS_FIN = 512;
constexpr size_t WS_EXP_FIN = 248 * MiB;
__device__ __forceinline__ void flag(float* F, int k, float e) { if (!(e >= 0.f)) e = 1e30f; atomicMax((int*)F + k, __float_as_int(e)); }
__device__ __forceinline__ float nerr(float got, float exp, float rel, float abst) { return fabsf(got - exp) / (rel * fabsf(exp) + abst); }
__device__ __forceinline__ float bsum(float v, float* red) {
    const int t = threadIdx.x; red[t] = v; __syncthreads();
    for (int o = 128; o > 0; o >>= 1) { if (t < o) red[t] += red[t + o]; __syncthreads(); }
    const float r = red[0]; __syncthreads(); return r;
}
__device__ __forceinline__ void load_u(const float* x, const float* g, int row, float* us, float* red) {
    const int t = threadIdx.x; float s = 0.f;
    for (int k = t; k < D; k += 256) { const float v = x[(size_t)row * D + k]; s += v * v; }
    const float r = rsqrtf(bsum(s, red) / D + EPS);
    for (int k = t; k < D; k += 256) us[k] = x[(size_t)row * D + k] * r * g[k];
    __syncthreads();
}
__device__ __forceinline__ float pdot(const float* us, const float* w_in, const float* b_in, int oc, float* red) {
    float s = 0.f; for (int k = threadIdx.x; k < D; k += 256) s += us[k] * w_in[(size_t)k * INW + oc];
    return bsum(s, red) + b_in[oc];
}
__device__ __forceinline__ unsigned mix(unsigned s) { unsigned h = s * 0x9E3779B1u; h ^= h >> 16; h *= 0x85EBCA6Bu; h ^= h >> 13; h *= 0xC2B2AE35u; h ^= h >> 16; return h; }
__device__ __forceinline__ float sg_(float v) { return 1.f / (1.f + __expf(-v)); }
__global__ void chk_p1(const float* x, const float* g, const float* w_in, const float* b_in, const bf16* AQ, const bf16* AK, const bf16* AV, const bf16* V, const bf16* SG, const bf16* SR, const bf16* SB, float* F) {
    __shared__ float us[1024], red[256];
    const unsigned hh_ = mix(blockIdx.x); const int row = (int)(hh_ % (unsigned)M), c = (int)((hh_ >> 14) % 1024u);
    load_u(x, g, row, us, red);
    const float aq = pdot(us, w_in, b_in, c, red), ak = pdot(us, w_in, b_in, 1024 + (c & 127), red), av = pdot(us, w_in, b_in, 1152 + (c & 127), red), hi = pdot(us, w_in, b_in, 3328 + c, red),
                hg = pdot(us, w_in, b_in, 4352 + c, red), ga = pdot(us, w_in, b_in, 5376 + c, red), gb = pdot(us, w_in, b_in, 6400 + c, red);
    if (threadIdx.x == 0) {
        float e = nerr(bf2f(AQ[(size_t)row * D + c]), aq * pg8::C2, 0.02f, 0.004f);
        e = fmaxf(e, nerr(bf2f(AK[(size_t)row * 128 + (c & 127)]), ak, 0.02f, 0.02f)); e = fmaxf(e, nerr(bf2f(AV[(size_t)row * 128 + (c & 127)]), av, 0.02f, 0.02f));
        e = fmaxf(e, nerr(bf2f(V[(size_t)row * D + c]), hi, 0.02f, 0.02f)); e = fmaxf(e, nerr(bf2f(SG[(size_t)row * D + c]), sg_(hg), 0.02f, 0.01f));
        e = fmaxf(e, nerr(bf2f(SB[(size_t)row * D + c]), sg_(gb), 0.02f, 0.01f)); e = fmaxf(e, nerr(bf2f(SR[(size_t)row * D + c]), sg_(ga) / sg_(gb), 0.03f, 0.02f));
        flag(F, 0, e); }
}
__global__ void chk_p1h(const float* x, const float* g, const float* w_in, const float* b_in, const float* lbl, const bf16* Q1, const bf16* K1, const float* BMID, const float* BLAST, float* F) {
    __shared__ float us[1024], red[256], hq[64], hf[64];
    const unsigned hh_ = mix(blockIdx.x + 77u); const int cr = (int)(hh_ % 256u), ch = (int)((hh_ >> 8) % 1024u);
    for (int r = 0; r < 64; ++r) { load_u(x, g, cr * 64 + r, us, red); const float a = pdot(us, w_in, b_in, 1280 + ch, red), b = pdot(us, w_in, b_in, 2304 + ch, red); if (threadIdx.x == 0) { hq[r] = a; hf[r] = b; } }
    __syncthreads();
    if (threadIdx.x == 0) {
        const float l0 = lbl[ch], l1 = lbl[1024 + ch], lb = 1.f / (1.f + __expf(l1 - l0));
        float cum = 0.f, e = 0.f;
        for (int r = 0; r < 64; ++r) { const float s = sg_(hf[r]), f = lb + (1.f - lb) * s; cum += log2f(f); hf[r] = cum; hq[r] = hq[r] * sg_(hq[r]); red[r] = (1.f - lb) * (1.f - s); }
        const float bm = hf[31], bl = hf[63];
        e = fmaxf(e, nerr(BMID[(size_t)cr * 1024 + ch], bm, 0.01f, 0.02f)); e = fmaxf(e, nerr(BLAST[(size_t)cr * 1024 + ch], bl, 0.01f, 0.02f));
        for (int r = 0; r < 64; ++r) { const float q1 = hq[r] * exp2f(hf[r] - bm), k1 = red[r] * exp2f(bm - hf[r]);
            e = fmaxf(e, nerr(bf2f(Q1[(size_t)(cr * 64 + r) * D + ch]), q1, 0.04f, 2e-2f * exp2f(hf[r] - bm))); e = fmaxf(e, nerr(bf2f(K1[(size_t)(cr * 64 + r) * D + ch]), k1, 0.04f, 2e-2f * exp2f(bm - hf[r]))); }
        flag(F, 1, e); }
}
__global__ void exp_attn(const bf16* AQ, const bf16* AK, const bf16* AV, const float* sinks, float* EX) {
    const int s = blockIdx.x * 4 + (threadIdx.x >> 6), d = threadIdx.x & 63; if (s >= NS_ATT) return;
    const unsigned hh_ = mix(s + 999u); const int tok = (int)(hh_ % (unsigned)M), hq = (int)((hh_ >> 14) % 16u), hkv = hq >> 3, b = tok >> 12, i = tok & 4095, j0 = i - 127 < 0 ? 0 : i - 127;
    const float q = bf2f(AQ[(size_t)tok * D + hq * 64 + d]);
    float m = sinks[hq] * pg8::LOG2E;
    for (int j = j0; j <= i; ++j) m = fmaxf(m, wave_sum(q * bf2f(AK[(size_t)(b * SEQ + j) * 128 + hkv * 64 + d])));
    float l = exp2f(sinks[hq] * pg8::LOG2E - m), o = 0.f;
    for (int j = j0; j <= i; ++j) { const float e = exp2f(wave_sum(q * bf2f(AK[(size_t)(b * SEQ + j) * 128 + hkv * 64 + d])) - m); l += e; o += e * bf2f(AV[(size_t)(b * SEQ + j) * 128 + hkv * 64 + d]); }
    EX[(size_t)s * 64 + d] = o / l;
}
__global__ void chk_attn(const bf16* YA, const float* EX, float* F) {
    const int s = blockIdx.x * 4 + (threadIdx.x >> 6), d = threadIdx.x & 63; if (s >= NS_ATT) return;
    const unsigned hh_ = mix(s + 999u); const int tok = (int)(hh_ % (unsigned)M), hq = (int)((hh_ >> 14) % 16u);
    flag(F, 2, nerr(bf2f(YA[(size_t)tok * D + hq * 64 + d]), EX[(size_t)s * 64 + d], 0.03f, 0.02f));
}
__global__ void exp_hgrn_p(const float* x, const float* g, const float* w_in, const float* b_in, int bb, int hh, float* PS) {
    __shared__ float us[1024], red[256];
    const int tok = blockIdx.x; load_u(x, g, bb * SEQ + tok, us, red);
    for (int c = 0; c < 512; ++c) { const int oc = (c < 128 ? 1280 : c < 256 ? 2304 : c < 384 ? 3328 : 4352) + hh * 128 + (c & 127); const float v = pdot(us, w_in, b_in, oc, red); if (threadIdx.x == 0) PS[(size_t)tok * 512 + c] = v; }
}
__global__ void chk_hgrn(const float* PS, const float* lbl, const float* ng, const bf16* YH, int bb, int hh, float* F) {
    __shared__ float fq[128], fk[128], ff[128], red[128], po[4][128];
    const int v = threadIdx.x & 127, kq = threadIdx.x >> 7; float S[32];
#pragma unroll
    for (int k = 0; k < 32; ++k) S[k] = 0.f;
    const float l0 = lbl[hh * 128 + v], l1 = lbl[1024 + hh * 128 + v], lb = 1.f / (1.f + __expf(l1 - l0));
    float emax = 0.f;
    for (int t = 0; t < HG_TOK; ++t) {
        const float* p = PS + (size_t)t * 512;
        if (kq == 0) { const float hq = p[v], hf = p[128 + v], s = sg_(hf); fq[v] = hq * sg_(hq); ff[v] = lb + (1.f - lb) * s; fk[v] = (1.f - lb) * (1.f - s); }
        __syncthreads();
        const float vv = p[256 + v]; float o = 0.f;
#pragma unroll
        for (int k = 0; k < 32; ++k) { S[k] = ff[kq * 32 + k] * S[k] + fk[kq * 32 + k] * vv; o += fq[kq * 32 + k] * S[k]; }
        po[kq][v] = o; __syncthreads();
        o = po[0][v] + po[1][v] + po[2][v] + po[3][v];
        if (kq == 0) red[v] = o * o;
        __syncthreads();
        for (int w = 64; w > 0; w >>= 1) { if (kq == 0 && v < w) red[v] += red[v + w]; __syncthreads(); }
        const float r = rsqrtf(red[0] / 128.f + EPS), y = o * r * ng[hh * 128 + v] * sg_(p[384 + v]);
        if (kq == 0) emax = fmaxf(emax, nerr(bf2f(YH[(size_t)(bb * SEQ + t) * D + hh * 128 + v]), y, 0.05f, 0.03f));
        __syncthreads();
    }
    if (kq == 0) flag(F, 3, emax);
}
__global__ void chk_mg(const bf16* YA, const bf16* YH, const bf16* SR, const bf16* SB, const float* wba, const float* wbh, const bf16* MG, float* F) {
    const int s = blockIdx.x * blockDim.x + threadIdx.x; const unsigned hh_ = mix(s + 31337u); const int row = (int)(hh_ % (unsigned)M), c = (int)((hh_ >> 14) % 1024u);
    float a = 0.f, b = 0.f; for (int k = 0; k < D; ++k) { a += bf2f(YA[(size_t)row * D + k]) * wba[(size_t)k * D + c]; b += bf2f(YH[(size_t)row * D + k]) * wbh[(size_t)k * D + c]; }
    const float sb = bf2f(SB[(size_t)row * D + c]), sr = bf2f(SR[(size_t)row * D + c]);
    flag(F, 4, nerr(bf2f(MG[(size_t)row * D + c]), sr * sb * a + sb * b, 0.03f, 0.02f));
}
__global__ void chk_h1(const float* x, const bf16* MG, const float* wout, const float* H1, const float* SSQ, float* F) {
    const int s = blockIdx.x * blockDim.x + threadIdx.x; const unsigned hh_ = mix(s + 31337u); const int row = (int)(hh_ % (unsigned)M), c = (int)((hh_ >> 14) % 1024u);
    float a = 0.f; for (int k = 0; k < D; ++k) a += bf2f(MG[(size_t)row * D + k]) * wout[(size_t)k * D + c];
    float e = nerr(H1[(size_t)row * D + c], x[(size_t)row * D + c] + a, 0.01f, 0.02f);
    float q = 0.f, p = 0.f; for (int k = 0; k < D; ++k) { const float v = H1[(size_t)row * D + k]; q += v * v; } for (int k = 0; k < 16; ++k) p += SSQ[(size_t)row * 16 + k];
    e = fmaxf(e, nerr(p, q, 0.001f, 0.f)); flag(F, 5, e);
}
__global__ void chk_z(const float* H1, const float* gffn, const float* wg, const float* wu, const bf16* Z, float* F) {
    __shared__ float red[256];
    const unsigned hh_ = mix(blockIdx.x + 4242u); const int row = (int)(hh_ % (unsigned)M), f = (int)((hh_ >> 14) % (unsigned)FF);
    float s = 0.f; for (int k = threadIdx.x; k < D; k += 256) { const float v = H1[(size_t)row * D + k]; s += v * v; }
    const float r = rsqrtf(bsum(s, red) / D + EPS);
    float a = 0.f, b = 0.f; for (int k = threadIdx.x; k < D; k += 256) { const float u = H1[(size_t)row * D + k] * r * gffn[k]; a += u * wg[(size_t)k * FF + f]; b += u * wu[(size_t)k * FF + f]; }
    a = bsum(a, red); b = bsum(b, red);
    if (threadIdx.x == 0) flag(F, 6, nerr(bf2f(Z[(size_t)row * FF + f]), a * sg_(a) * b, 0.04f, 0.02f));
}
__global__ void chk_h2(const bf16* H1b, const bf16* Z, const float* wd, const float* H2, float* F) {
    const int s = blockIdx.x * blockDim.x + threadIdx.x; const unsigned hh_ = mix(s + 31337u); const int row = (int)(hh_ % (unsigned)M), c = (int)((hh_ >> 14) % 1024u);
    float a = 0.f; for (int k = 0; k < FF; ++k) a += bf2f(Z[(size_t)row * FF + k]) * wd[(size_t)k * D + c];
    flag(F, 7, nerr(H2[(size_t)row * D + c], bf2f(H1b[(size_t)row * D + c]) + a, 0.02f, 0.03f));
}
__global__ void exp_final(const float* H2, const float* gfin, float* EXF) {
    __shared__ float red[256];
    const int row = (int)((blockIdx.x * 2654435761u) % (unsigned)M);
    float s = 0.f; for (int k = threadIdx.x; k < D; k += 256) { const float v = H2[(size_t)row * D + k]; s += v * v; }
    const float r = rsqrtf(bsum(s, red) / D + EPS);
    for (int k = threadIdx.x; k < D; k += 256) EXF[(size_t)blockIdx.x * D + k] = H2[(size_t)row * D + k] * r * gfin[k];
}
__global__ void chk_final(const float* OUT, const float* EXF, float* F) {
    const int row = (int)((blockIdx.x * 2654435761u) % (unsigned)M); float e = 0.f;
    for (int k = threadIdx.x; k < D; k += 256) if (!(row == 0 && k == 0)) e = fmaxf(e, nerr(OUT[(size_t)row * D + k], EXF[(size_t)blockIdx.x * D + k], 0.001f, 0.001f));
    flag(F, 8, e);
}
__global__ void cksum(const unsigned* p, size_t nwords, unsigned long long* acc) {
    unsigned long long s = 0; for (size_t i = (size_t)blockIdx.x * blockDim.x + threadIdx.x; i < nwords; i += (size_t)gridDim.x * blockDim.x) { const unsigned w = p[i]; s += (unsigned long long)w * (unsigned long long)((i & 0xffff) + 1); }
    for (int o = 32; o > 0; o >>= 1) s += __shfl_down(s, o);
    if ((threadIdx.x & 63) == 0) atomicAdd(acc, s);
}
__global__ void ckcmp(const unsigned long long* a, const unsigned long long* b, int n, float* F, int k) { bool bad = false; for (int i = 0; i < n; ++i) bad |= a[i] != b[i]; if (bad) F[k] = 2.f; }
__global__ void report(const float* F, float* out, int base) {
    int code = 0; for (int k = 0; k < 6; ++k) if (!(F[base + k] <= 1.f)) code |= 1 << k;
    out[0] = 10.f * code + 5.f;
}
}
#endif

#if defined(MK_DEBUG) && MK_DEBUG >= 3
namespace nv {
constexpr int D = 1024, INW = 7424, F = 2816;
constexpr int O_AQ = 0, O_AK = 1024, O_AV = 1152, O_HQ = 1280, O_HF = 2304, O_HI = 3328, O_HG = 4352, O_GA = 5376, O_GB = 6400;
constexpr float EPS = 1e-6f;

__global__ void k_rmsnorm(const float* __restrict__ x, const float* __restrict__ g, float* __restrict__ out) {
    const int row = blockIdx.x, t = threadIdx.x;
    const float4 v = ((const float4*)(x + (size_t)row * D))[t];
    float s = v.x * v.x + v.y * v.y + v.z * v.z + v.w * v.w;
    __shared__ float red[256];
    red[t] = s; __syncthreads();
    for (int o = 128; o > 0; o >>= 1) { if (t < o) red[t] += red[t + o]; __syncthreads(); }
    const float r = rsqrtf(red[0] / D + EPS);
    const float4 gv = ((const float4*)g)[t];
    float4 o4; o4.x = v.x * r * gv.x; o4.y = v.y * r * gv.y; o4.z = v.z * r * gv.z; o4.w = v.w * r * gv.w;
    ((float4*)(out + (size_t)row * D))[t] = o4;
}

__global__ void k_gemm(const float* __restrict__ A, int lda, const float* __restrict__ W, int ldw, const float* __restrict__ bias,
                       const float* __restrict__ res, int ldres, float* __restrict__ C, int ldc, int K) {
    __shared__ float As[16][65], Ws[16][65];
    const int t = threadIdx.x, tx = t & 15, ty = t >> 4, m0 = blockIdx.y * 64, n0 = blockIdx.x * 64;
    float acc[4][4] = {};
    for (int k0 = 0; k0 < K; k0 += 16) {
        for (int i = t; i < 64 * 16; i += 256) { const int r = i >> 4, c = i & 15; As[c][r] = A[(size_t)(m0 + r) * lda + k0 + c]; }
        for (int i = t; i < 16 * 64; i += 256) { const int r = i >> 6, c = i & 63; Ws[r][c] = W[(size_t)(k0 + r) * ldw + n0 + c]; }
        __syncthreads();
#pragma unroll
        for (int k = 0; k < 16; ++k) {
            float a[4], b[4];
#pragma unroll
            for (int i = 0; i < 4; ++i) { a[i] = As[k][ty * 4 + i]; b[i] = Ws[k][tx * 4 + i]; }
#pragma unroll
            for (int i = 0; i < 4; ++i)
#pragma unroll
                for (int j = 0; j < 4; ++j) acc[i][j] += a[i] * b[j];
        }
        __syncthreads();
    }
#pragma unroll
    for (int i = 0; i < 4; ++i)
#pragma unroll
        for (int j = 0; j < 4; ++j) {
            const int m = m0 + ty * 4 + i, n = n0 + tx * 4 + j;
            float v = acc[i][j]; if (bias) v += bias[n]; if (res) v += res[(size_t)m * ldres + n];
            C[(size_t)m * ldc + n] = v;
        }
}

__global__ void k_attn(const float* __restrict__ p, const float* __restrict__ sinks, float* __restrict__ y, int S) {
    const int w = (blockIdx.x * blockDim.x + threadIdx.x) >> 6, d = threadIdx.x & 63;
    const int hq = w & 15, i = w >> 4, hkv = hq >> 3;
    const float q = p[(size_t)i * INW + O_AQ + hq * 64 + d];
    const int j0 = i - 127 < 0 ? 0 : i - 127;
    float m = sinks[hq], l = 1.f, o = 0.f;
    for (int j = j0; j <= i; ++j) {
        float s = q * p[(size_t)j * INW + O_AK + hkv * 64 + d];
#pragma unroll
        for (int x = 1; x < 64; x <<= 1) s += __shfl_xor(s, x);
        s *= 0.125f;
        const float mn = fmaxf(m, s), a = __expf(m - mn), e = __expf(s - mn);
        l = l * a + e; o = o * a + e * p[(size_t)j * INW + O_AV + hkv * 64 + d]; m = mn;
    }
    y[(size_t)i * D + hq * 64 + d] = o / l;
}

__global__ void k_hgrn(const float* __restrict__ p, const float* __restrict__ lbl, const float* __restrict__ ng, float* __restrict__ o_raw, int S) {
    const int h = blockIdx.x >> 3, vs = blockIdx.x & 7, t = threadIdx.x, kq = t >> 4, v = t & 15;
    __shared__ float part[16][17];
    float lb[8], st[8];
#pragma unroll
    for (int i = 0; i < 8; ++i) { const int ch = h * 128 + kq * 8 + i; const float l0 = lbl[ch], l1 = lbl[1024 + ch]; const float mx = fmaxf(l0, l1); const float e0 = __expf(l0 - mx), e1 = __expf(l1 - mx); lb[i] = e0 / (e0 + e1); st[i] = 0.f; }
    for (int tok = 0; tok < S; ++tok) {
        const float* row = p + (size_t)tok * INW;
        const float vv = row[O_HI + h * 128 + vs * 16 + v];
        float po = 0.f;
#pragma unroll
        for (int i = 0; i < 8; ++i) { const int ch = h * 128 + kq * 8 + i; const float fp = row[O_HF + ch], hq = row[O_HQ + ch];
            const float sg = 1.f / (1.f + __expf(-fp)); const float f = lb[i] + (1.f - lb[i]) * sg; const float kk = (1.f - lb[i]) * (1.f - sg); const float q = hq / (1.f + __expf(-hq));
            st[i] = f * st[i] + kk * vv; po += q * st[i]; }
        part[kq][v] = po; __syncthreads();
        if (t < 16) { float s = 0.f;
#pragma unroll
            for (int i = 0; i < 16; ++i) s += part[i][t];
            o_raw[(size_t)tok * D + h * 128 + vs * 16 + t] = s; }
        __syncthreads();
    }
}
__global__ void k_hgrn_post(const float* __restrict__ o_raw, const float* __restrict__ p, const float* __restrict__ ng, float* __restrict__ y) {
    const int tok = blockIdx.x >> 3, h = blockIdx.x & 7, t = threadIdx.x;
    const float o = o_raw[(size_t)tok * D + h * 128 + t];
    __shared__ float red[128]; red[t] = o * o; __syncthreads();
    for (int s = 64; s > 0; s >>= 1) { if (t < s) red[t] += red[t + s]; __syncthreads(); }
    const float r = rsqrtf(red[0] / 128.f + EPS); const float hg = p[(size_t)tok * INW + O_HG + h * 128 + t];
    y[(size_t)tok * D + h * 128 + t] = o * r * ng[h * 128 + t] / (1.f + __expf(-hg));
}
__global__ void k_merge(const float* __restrict__ p, const float* __restrict__ ya, const float* __restrict__ yb, float* __restrict__ mg) {
    const int idx = blockIdx.x * blockDim.x + threadIdx.x; const int tok = idx >> 10, c = idx & 1023;
    const float ga = p[(size_t)tok * INW + O_GA + c], gb = p[(size_t)tok * INW + O_GB + c];
    mg[idx] = ya[idx] / (1.f + __expf(-ga)) + yb[idx] / (1.f + __expf(-gb));
}
__global__ void k_swiglu(const float* __restrict__ g, const float* __restrict__ u, float* __restrict__ z, int n) {
    const int idx = blockIdx.x * blockDim.x + threadIdx.x; if (idx < n) { const float a = g[idx]; z[idx] = a / (1.f + __expf(-a)) * u[idx]; }
}
}
namespace dbg3 {
using dbg::flag; using dbg::nerr; using dbg::sg_;
constexpr int SR_ = 128;
__global__ void cmp_p1(const float* p, const float* lbl, const bf16* AQ, const bf16* AK, const bf16* AV, const bf16* Q1, const bf16* K1, const bf16* V, const bf16* SG, const bf16* SR, const bf16* SB, const float* BMID, const float* BLAST, float* F) {
    const int idx = blockIdx.x * blockDim.x + threadIdx.x, row = idx >> 10, c = idx & 1023; const float* pr = p + (size_t)row * nv::INW;
    flag(F, 0, nerr(bf2f(AQ[(size_t)row * D + c]), pr[c] * pg8::C2, 0.02f, 0.004f));
    if (c < 128) { flag(F, 0, nerr(bf2f(AK[(size_t)row * 128 + c]), pr[1024 + c], 0.02f, 0.02f)); flag(F, 0, nerr(bf2f(AV[(size_t)row * 128 + c]), pr[1152 + c], 0.02f, 0.02f)); }
    flag(F, 1, nerr(bf2f(V[(size_t)row * D + c]), pr[3328 + c], 0.02f, 0.02f)); flag(F, 1, nerr(bf2f(SG[(size_t)row * D + c]), sg_(pr[4352 + c]), 0.03f, 0.02f));
    flag(F, 2, nerr(bf2f(SB[(size_t)row * D + c]), sg_(pr[6400 + c]), 0.03f, 0.02f)); flag(F, 2, nerr(bf2f(SR[(size_t)row * D + c]), sg_(pr[5376 + c]) / sg_(pr[6400 + c]), 0.05f, 0.03f));
    const int ck = row >> 6, r0 = ck * 64; const float l0 = lbl[c], l1 = lbl[1024 + c], lb = 1.f / (1.f + __expf(l1 - l0));
    float cum = 0.f, bm = 0.f, bl = 0.f, brow = 0.f;
    for (int r = r0; r < r0 + 64; ++r) { const float s = sg_(p[(size_t)r * nv::INW + 2304 + c]); cum += log2f(lb + (1.f - lb) * s); if (r == row) brow = cum; if (r == r0 + 31) bm = cum; if (r == r0 + 63) bl = cum; }
    const float hq = pr[1280 + c], s = sg_(pr[2304 + c]);
    flag(F, 3, nerr(bf2f(Q1[(size_t)row * D + c]), hq * sg_(hq) * exp2f(brow - bm), 0.04f, 2e-2f * exp2f(brow - bm)));
    flag(F, 3, nerr(bf2f(K1[(size_t)row * D + c]), (1.f - lb) * (1.f - s) * exp2f(bm - brow), 0.04f, 2e-2f * exp2f(bm - brow)));
    flag(F, 3, nerr(BMID[(size_t)ck * 1024 + c], bm, 0.01f, 0.03f)); flag(F, 3, nerr(BLAST[(size_t)ck * 1024 + c], bl, 0.01f, 0.03f));
}
__global__ void cmp_bf(const bf16* got, const float* exp, int ld_exp, float rel, float abst, float* F, int k) {
    const int idx = blockIdx.x * blockDim.x + threadIdx.x, row = idx >> 10, c = idx & 1023; flag(F, k, nerr(bf2f(got[(size_t)row * D + c]), exp[(size_t)row * ld_exp + c], rel, abst));
}
__global__ void cmp_f32(const float* got, const float* exp, float rel, float abst, float* F, int k) {
    const int idx = blockIdx.x * blockDim.x + threadIdx.x; if (idx == 0) return; flag(F, k, nerr(got[idx], exp[idx], rel, abst));
}
__global__ void cmp_z(const bf16* got, const float* exp, float* F, int k, int n) {
    const int idx = blockIdx.x * blockDim.x + threadIdx.x; if (idx < n) flag(F, k, nerr(bf2f(got[idx]), exp[idx], 0.04f, 0.03f));
}
}
#endif

#if defined(MK_DEBUG) && MK_DEBUG == 4
namespace dbg4 {
__global__ void cmp_rows(const float* got, const float* exp, int row0, unsigned* ST) {
    __shared__ int cnt; if (threadIdx.x == 0) cnt = 0; __syncthreads();
    const int row = blockIdx.x; int bad = 0;
    for (int k = threadIdx.x; k < D; k += 256) { const float g = got[(size_t)(row0 + row) * D + k], e = exp[(size_t)row * D + k]; if (!(fabsf(g - e) <= 0.05f + 0.02f * fabsf(e))) ++bad; }
    if (bad) atomicAdd(&cnt, bad); __syncthreads();
    if (threadIdx.x == 0 && cnt > 0) { atomicAdd(ST + 0, 1u); atomicMin(ST + 1, (unsigned)(row0 + row)); atomicMax(ST + 2, (unsigned)(row0 + row)); atomicAdd(ST + 5, (unsigned)cnt); if (((row0 + row) & 15) == 15) atomicAdd(ST + 6, 1u); if (((row0 + row) & 63) == 63) atomicAdd(ST + 7, 1u); if (((row0 + row) & 15) == 0) atomicAdd(ST + 8, 1u); if (row0 + row >= 15360) atomicAdd(ST + 9, 1u); if (((row0 + row) & 4095) >= 3840) atomicAdd(ST + 10, 1u); if (((row0 + row) & 4095) < 256) atomicAdd(ST + 11, 1u); if ((row0 + row) & 1) atomicAdd(ST + 12, 1u); if ((row0 + row) & 8) atomicAdd(ST + 13, 1u); if (((row0 + row) & 127) < 8) atomicAdd(ST + 14, 1u); if (((row0 + row) & 63) < 8) atomicAdd(ST + 15, 1u); atomicMin(ST + 16, (unsigned)((row0 + row) & 127)); atomicMax(ST + 17, (unsigned)((row0 + row) & 127)); atomicMin(ST + 18, (unsigned)((row0 + row) & 2047)); atomicMax(ST + 19, (unsigned)((row0 + row) & 2047)); }
}
__global__ void cmp_cols(const float* got, const float* exp, int row0, int nrows, unsigned* ST) {
    const unsigned fr = ST[1]; if (fr < (unsigned)row0 || fr >= (unsigned)(row0 + nrows)) return;
    for (int k = threadIdx.x; k < D; k += 256) { const float g = got[(size_t)fr * D + k], e = exp[(size_t)(fr - row0) * D + k]; if (!(fabsf(g - e) <= 0.05f + 0.02f * fabsf(e))) { atomicAdd(ST + 3, 1u); atomicMin(ST + 4, (unsigned)k); } }
}
__global__ void report4(const unsigned* ST, float* out, int sel) { out[0] = 5.f + 10.f * (float)(sel == 5 ? ST[5] / 1024u : ST[sel]); }
}
#endif

#if defined(MK_DEBUG) && MK_DEBUG == 5
namespace dbg5 {
__global__ void nancount(const unsigned* p, size_t nwords, int f32mode, unsigned* CNT, int slot) {
    unsigned c = 0;
    for (size_t i = (size_t)blockIdx.x * blockDim.x + threadIdx.x; i < nwords; i += (size_t)gridDim.x * blockDim.x) { const unsigned w = p[i];
        if (f32mode == 1) { if ((w & 0x7f800000u) == 0x7f800000u) ++c; } else if (f32mode == 0) { if ((w & 0x7f80u) == 0x7f80u) ++c; if ((w & 0x7f800000u) == 0x7f800000u) ++c; }
        else { const float lo = __builtin_bit_cast(float, w << 16), hi = __builtin_bit_cast(float, w & 0xffff0000u); const bool b0 = !(fabsf(lo) <= 16.f), b1 = !(fabsf(hi) <= 16.f); if (b0) ++c; if (b1) ++c; if (b0 || b1) { const size_t e = 2 * i; if ((e & 1023) >= 896) atomicAdd(CNT + 20 + slot, 1u); atomicMin(CNT + 30 + slot, (unsigned)(e >> 10)); atomicMax(CNT + 40 + slot, (unsigned)(e >> 10)); atomicMin(CNT + 50 + slot, (unsigned)(e & 1023)); atomicMax(CNT + 60 + slot, (unsigned)(e & 1023)); const float mx = fmaxf(b0 ? fabsf(lo) : 0.f, b1 ? fabsf(hi) : 0.f); atomicMax(CNT + 70 + slot, (unsigned)fminf(mx, 1e6f)); atomicMin(CNT + 80 + slot, (unsigned)fminf(mx, 1e6f)); if (e >= 8) { const unsigned pw = p[i - 4]; if (!(fabsf(__builtin_bit_cast(float, pw << 16)) <= 16.f)) atomicAdd(CNT + 90 + slot, 1u); } } } }
    if (c) atomicAdd(CNT + slot, c);
}
__global__ void report5(const unsigned* CNT, float* out, int sel) {
    if (sel < 0) { int first = 0; for (int k = 0; k < 16; ++k) if (CNT[k] && !first) first = k + 1; out[0] = 5.f + 10.f * first; }
    else out[0] = 5.f + 10.f * (float)(CNT[sel] > 4000000u ? 4000000u : CNT[sel]);
}
}
#endif
#ifndef MK_N_LAUNCHES
#define MK_N_LAUNCHES 1
#endif
extern "C" void kernel_launch(void* const* d_in, const int* in_sizes, int n_in, void* d_out, int out_size, void* d_ws, size_t ws_size, hipStream_t stream) {
    static int grid = 0;
    if (grid == 0) {
        if (n_in != 15 || in_sizes[0] != M * D || out_size != M * D || ws_size < WS_END) { fprintf(stderr, "kernel_launch: unexpected shapes (n_in %d, in0 %d, out %d, ws %zu); nothing launched\n", n_in, n_in > 0 ? in_sizes[0] : -1, out_size, ws_size); grid = -1; return; }
        int dev = 0, cus = 0, per_cu = 0;
        if (hipGetDevice(&dev) != hipSuccess || hipDeviceGetAttribute(&cus, hipDeviceAttributeMultiprocessorCount, dev) != hipSuccess) { grid = -1; return; }
        if (hipFuncSetAttribute((const void*)mk_fwd, hipFuncAttributeMaxDynamicSharedMemorySize, LDS_BYTES) != hipSuccess) { fprintf(stderr, "kernel_launch: hipFuncSetAttribute failed\n"); grid = -1; return; }
        if (hipOccupancyMaxActiveBlocksPerMultiprocessor(&per_cu, (const void*)mk_fwd, NWAVES * 64, LDS_BYTES) != hipSuccess || per_cu < 1) { fprintf(stderr, "kernel_launch: occupancy query says %d blocks per CU\n", per_cu); per_cu = 1; }
        (void)hipGetLastError();
        grid = cus;
        if (grid != 256) fprintf(stderr, "kernel_launch: %d CUs (expected 256)\n", grid);
    }
    if (grid < 0) return;
    if (hipMemsetAsync((char*)d_ws + WS_CTL, 0, CTL_ZERO_BYTES, stream) != hipSuccess) return;
    Args a{};
    for (int i = 0; i < 15; ++i) a.in[i] = (const float*)d_in[i];
    a.out = (float*)d_out; a.ws = (unsigned char*)d_ws;
#define LAUNCH_PH(lo_, hi_) do { a.ph_lo = (lo_); a.ph_hi = (hi_); hipLaunchKernelGGL(mk_fwd, dim3(grid), dim3(NWAVES * 64), LDS_BYTES, stream, a); } while (0)
#if defined(MK_DEBUG) && MK_DEBUG == 5
    {
        using namespace dbg5; unsigned char* ws = (unsigned char*)d_ws; float* out = (float*)d_out;
        unsigned* CNT = (unsigned*)(ws + 250 * MiB);
        hipMemsetAsync(ws + 1 * MiB, 0xFF, 242 * MiB, stream); hipMemsetAsync(out, 0xFF, (size_t)M * D * 4, stream); hipMemsetAsync(CNT, 0, 512, stream); hipMemsetAsync(CNT + 30, 0xff, 40, stream); hipMemsetAsync(CNT + 50, 0xff, 40, stream); hipMemsetAsync(CNT + 80, 0xff, 40, stream);
#define NC(ptr, bytes, f32, slot) nancount<<<1024, 256, 0, stream>>>((const unsigned*)(ptr), (size_t)(bytes) / 4, (f32), CNT, (slot))
        LAUNCH_PH(0, 1); LAUNCH_PH(1, 2);
        NC(ws + WS_V, 32 * MiB, 2, 0); NC(ws + WS_SG, 32 * MiB, 2, 1); NC((unsigned char*)out + 32 * MiB, 32 * MiB, 2, 2); NC(ws + WS_AK, 8 * MiB, 2, 3);
        LAUNCH_PH(2, 3); NC(ws + WS_AQ, 32 * MiB, 2, 4); NC(ws + WS_SG, 32 * MiB, 2, 5);
        LAUNCH_PH(3, 4); NC(ws + WS_MG, 32 * MiB, 2, 6);
        LAUNCH_PH(4, 5); LAUNCH_PH(5, 6); LAUNCH_PH(6, 7); LAUNCH_PH(7, 8);
        report5<<<1, 1, 0, stream>>>(CNT, out, DBG3_BASE);
    }
#elif defined(MK_DEBUG) && MK_DEBUG == 4
    {
        using namespace dbg4; unsigned char* ws = (unsigned char*)d_ws; float* out = (float*)d_out; constexpr int S = SEQ;
        LAUNCH_PH(0, N_PHASES);
        float* SAVE = (float*)(ws + 180 * MiB); unsigned* ST = (unsigned*)(ws + 250 * MiB);
        hipMemcpyAsync(SAVE, out, (size_t)M * D * 4, hipMemcpyDeviceToDevice, stream);
        hipMemsetAsync(ST, 0, 128, stream); hipMemsetAsync(ST + 1, 0xff, 4, stream); hipMemsetAsync(ST + 4, 0xff, 4, stream); hipMemsetAsync(ST + 16, 0xff, 4, stream); hipMemsetAsync(ST + 18, 0xff, 4, stream);
        const float* x = a.in[0]; const size_t SD = (size_t)S * D; float* w = (float*)ws;
        float* U = w; float* P = U + SD; float* YAT = P + (size_t)S * nv::INW; float* YHG = YAT + SD; float* ORAW = YHG + SD;
        for (int b = 0; b < BATCH; ++b) {
            const float* xb = x + (size_t)b * SD;
            nv::k_rmsnorm<<<S, 256, 0, stream>>>(xb, a.in[1], U);
            nv::k_gemm<<<dim3(nv::INW / 64, S / 64), 256, 0, stream>>>(U, D, a.in[2], nv::INW, a.in[3], nullptr, 0, P, nv::INW, D);
            nv::k_attn<<<S * 16 / 4, 256, 0, stream>>>(P, a.in[4], YAT, S);
            nv::k_hgrn<<<64, 256, 0, stream>>>(P, a.in[5], a.in[6], ORAW, S);
            nv::k_hgrn_post<<<S * 8, 128, 0, stream>>>(ORAW, P, a.in[6], YHG);
            nv::k_gemm<<<dim3(D / 64, S / 64), 256, 0, stream>>>(YAT, D, a.in[7], D, nullptr, nullptr, 0, U, D, D);
            nv::k_gemm<<<dim3(D / 64, S / 64), 256, 0, stream>>>(YHG, D, a.in[8], D, nullptr, nullptr, 0, ORAW, D, D);
            nv::k_merge<<<S * D / 256, 256, 0, stream>>>(P, U, ORAW, YAT);
            nv::k_gemm<<<dim3(D / 64, S / 64), 256, 0, stream>>>(YAT, D, a.in[9], D, nullptr, xb, D, YHG, D, D);
            nv::k_rmsnorm<<<S, 256, 0, stream>>>(YHG, a.in[10], U);
            float* GT = P; float* UP = P + (size_t)S * nv::F; float* Z = UP + (size_t)S * nv::F;
            nv::k_gemm<<<dim3(nv::F / 64, S / 64), 256, 0, stream>>>(U, D, a.in[11], nv::F, nullptr, nullptr, 0, GT, nv::F, D);
            nv::k_gemm<<<dim3(nv::F / 64, S / 64), 256, 0, stream>>>(U, D, a.in[12], nv::F, nullptr, nullptr, 0, UP, nv::F, D);
            nv::k_swiglu<<<(S * nv::F + 255) / 256, 256, 0, stream>>>(GT, UP, Z, S * nv::F);
            nv::k_gemm<<<dim3(D / 64, S / 64), 256, 0, stream>>>(Z, nv::F, a.in[13], D, nullptr, YHG, D, ORAW, D, nv::F);
            nv::k_rmsnorm<<<S, 256, 0, stream>>>(ORAW, a.in[14], U);
            cmp_rows<<<S, 256, 0, stream>>>(SAVE, U, b * S, ST);
            cmp_cols<<<1, 256, 0, stream>>>(SAVE, U, b * S, S, ST);
        }
        report4<<<1, 1, 0, stream>>>(ST, out, DBG3_BASE);
    }
#elif defined(MK_DEBUG) && MK_DEBUG == 3
    {
        using namespace dbg3; unsigned char* ws = (unsigned char*)d_ws; float* out = (float*)d_out; constexpr int S3 = SR_;
        const float* x = a.in[0]; const float* sinks = a.in[4]; const float* lbl = a.in[5]; const float* ng = a.in[6];
        bf16* AQ = (bf16*)(ws + WS_AQ); bf16* AK = (bf16*)(ws + WS_AK); bf16* AV = (bf16*)(ws + WS_AV); bf16* Q1 = (bf16*)(ws + WS_Q1); bf16* K1 = (bf16*)(ws + WS_K1); bf16* V = (bf16*)(ws + WS_V); bf16* SG = (bf16*)(ws + WS_SG);
        bf16* MG = (bf16*)(ws + WS_MG); bf16* SR = (bf16*)out; bf16* SB = SR + (size_t)M * D; float* BMID = (float*)(ws + WS_BM); float* BLAST = (float*)(ws + WS_BL);
        float* FL = (float*)(ws + 243 * MiB); float* nb = (float*)(ws + 243 * MiB + 65536);
        float* nu = nb; float* np_ = nu + S3 * D; float* nyat = np_ + (size_t)S3 * nv::INW; float* nyhg = nyat + S3 * D; float* noraw = nyhg + S3 * D; float* nya = noraw + S3 * D; float* nyb = nya + S3 * D;
        float* nmg = nyb + S3 * D; float* nh1 = nmg + S3 * D; float* nfin = nh1 + S3 * D; float* ngt = nu; float* nup = nya; float* nz = nyat; float* nh2 = nmg;
        hipMemsetAsync(FL, 0, 256, stream);
        nv::k_rmsnorm<<<S3, 256, 0, stream>>>(x, a.in[1], nu);
        nv::k_gemm<<<dim3(nv::INW / 64, S3 / 64), 256, 0, stream>>>(nu, D, a.in[2], nv::INW, a.in[3], nullptr, 0, np_, nv::INW, D);
        nv::k_attn<<<S3 * 16 / 4, 256, 0, stream>>>(np_, sinks, nyat, S3);
        nv::k_hgrn<<<64, 256, 0, stream>>>(np_, lbl, ng, noraw, S3);
        nv::k_hgrn_post<<<S3 * 8, 128, 0, stream>>>(noraw, np_, ng, nyhg);
        nv::k_gemm<<<dim3(D / 64, S3 / 64), 256, 0, stream>>>(nyat, D, a.in[7], D, nullptr, nullptr, 0, nya, D, D);
        nv::k_gemm<<<dim3(D / 64, S3 / 64), 256, 0, stream>>>(nyhg, D, a.in[8], D, nullptr, nullptr, 0, nyb, D, D);
        nv::k_merge<<<S3 * D / 256, 256, 0, stream>>>(np_, nya, nyb, nmg);
        nv::k_gemm<<<dim3(D / 64, S3 / 64), 256, 0, stream>>>(nmg, D, a.in[9], D, nullptr, x, D, nh1, D, D);
        LAUNCH_PH(0, 1); LAUNCH_PH(1, 2);
        cmp_p1<<<S3 * 1024 / 256, 256, 0, stream>>>(np_, lbl, AQ, AK, AV, Q1, K1, V, SG, SR, SB, BMID, BLAST, FL);
        LAUNCH_PH(2, 3);
        cmp_bf<<<S3 * 1024 / 256, 256, 0, stream>>>(AQ, nyat, D, 0.03f, 0.02f, FL, 4);
        cmp_bf<<<S3 * 1024 / 256, 256, 0, stream>>>(SG, nyhg, D, 0.05f, 0.03f, FL, 5);
        LAUNCH_PH(3, 4);
        cmp_bf<<<S3 * 1024 / 256, 256, 0, stream>>>(MG, nmg, D, 0.04f, 0.03f, FL, 6);
        LAUNCH_PH(4, 5);
        cmp_f32<<<S3 * 1024 / 256, 256, 0, stream>>>(out, nh1, 0.01f, 0.03f, FL, 7);
        nv::k_rmsnorm<<<S3, 256, 0, stream>>>(nh1, a.in[10], nfin);
        nv::k_gemm<<<dim3(nv::F / 64, S3 / 64), 256, 0, stream>>>(nfin, D, a.in[11], nv::F, nullptr, nullptr, 0, ngt, nv::F, D);
        nv::k_gemm<<<dim3(nv::F / 64, S3 / 64), 256, 0, stream>>>(nfin, D, a.in[12], nv::F, nullptr, nullptr, 0, nup, nv::F, D);
        nv::k_swiglu<<<(S3 * nv::F + 255) / 256, 256, 0, stream>>>(ngt, nup, nz, S3 * nv::F);
        LAUNCH_PH(5, 6);
        cmp_z<<<(S3 * 2816 + 255) / 256, 256, 0, stream>>>((bf16*)(ws + WS_Z), nz, FL, 8, S3 * 2816);
        nv::k_gemm<<<dim3(D / 64, S3 / 64), 256, 0, stream>>>(nz, nv::F, a.in[13], D, nullptr, nh1, D, nh2, D, nv::F);
        LAUNCH_PH(6, 7);
        cmp_f32<<<S3 * 1024 / 256, 256, 0, stream>>>(out, nh2, 0.01f, 0.03f, FL, 9);
        dbg::report<<<1, 1, 0, stream>>>(FL, out, DBG3_BASE);
    }
#elif defined(MK_DEBUG) && MK_DEBUG == 2
    {
        using namespace dbg; unsigned char* ws = (unsigned char*)d_ws; float* out = (float*)d_out;
        float* FL = (float*)(ws + WS_FLAGS); unsigned long long* CK = (unsigned long long*)(ws + WS_FLAGS + 4096);
        hipMemsetAsync(FL, 0, 8192, stream);
        int slot = 0;
#define CKS(ptr, bytes) do { cksum<<<1024, 256, 0, stream>>>((const unsigned*)(ptr), (size_t)(bytes) / 4, CK + slot); ++slot; } while (0)
#define CMP(n, bit) do { ckcmp<<<1, 1, 0, stream>>>(CK + slot - 2 * (n), CK + slot - (n), (n), FL, (bit)); } while (0)
        LAUNCH_PH(0, 1); CKS(ws + WS_WIN, 70 * MiB); LAUNCH_PH(0, 1); CKS(ws + WS_WIN, 70 * MiB); CMP(1, 0);
        LAUNCH_PH(1, 2); CKS(ws + WS_AQ, 168 * MiB); CKS(out, 64 * MiB); CKS(ws + WS_BM, 2 * MiB);
        LAUNCH_PH(1, 2); CKS(ws + WS_AQ, 168 * MiB); CKS(out, 64 * MiB); CKS(ws + WS_BM, 2 * MiB); CMP(3, 1);
        LAUNCH_PH(2, 3); CKS(ws + WS_AQ, 32 * MiB); CKS(ws + WS_SG, 32 * MiB);
        LAUNCH_PH(1, 2); LAUNCH_PH(2, 3); CKS(ws + WS_AQ, 32 * MiB); CKS(ws + WS_SG, 32 * MiB); CMP(2, 2);
        LAUNCH_PH(3, 4); CKS(ws + WS_MG, 32 * MiB); LAUNCH_PH(3, 4); CKS(ws + WS_MG, 32 * MiB); CMP(1, 3);
        LAUNCH_PH(4, 5); CKS(out, 64 * MiB); CKS(ws + WS_XN, 32 * MiB); CKS(ws + WS_SSQ, 1 * MiB);
        LAUNCH_PH(4, 5); CKS(out, 64 * MiB); CKS(ws + WS_XN, 32 * MiB); CKS(ws + WS_SSQ, 1 * MiB); CMP(3, 4);
        LAUNCH_PH(5, 6); CKS(ws + WS_Z, 88 * MiB); LAUNCH_PH(5, 6); CKS(ws + WS_Z, 88 * MiB); CMP(1, 5);
        LAUNCH_PH(6, 7); LAUNCH_PH(7, 8);
        report<<<1, 1, 0, stream>>>(FL, out, 0);
    }
#elif defined(MK_DEBUG)
    {
        using namespace dbg; unsigned char* ws = (unsigned char*)d_ws; float* out = (float*)d_out;
        const float* x = a.in[0]; const float* g = a.in[1]; const float* w_in = a.in[2]; const float* b_in = a.in[3]; const float* sinks = a.in[4]; const float* lbl = a.in[5]; const float* ng = a.in[6];
        bf16* AQ = (bf16*)(ws + WS_AQ); bf16* AK = (bf16*)(ws + WS_AK); bf16* AV = (bf16*)(ws + WS_AV); bf16* Q1 = (bf16*)(ws + WS_Q1); bf16* K1 = (bf16*)(ws + WS_K1); bf16* V = (bf16*)(ws + WS_V); bf16* SG = (bf16*)(ws + WS_SG);
        bf16* MG = (bf16*)(ws + WS_MG); bf16* SR = (bf16*)out; bf16* SB = SR + (size_t)M * D; float* BMID = (float*)(ws + WS_BM); float* BLAST = (float*)(ws + WS_BL); float* SSQ = (float*)(ws + WS_SSQ);
        float* FL = (float*)(ws + WS_FLAGS); float* EX = (float*)(ws + WS_EXP_ATT); float* PS = (float*)(ws + WS_PSM);
        hipMemsetAsync(FL, 0, 256, stream);
        LAUNCH_PH(0, 1); LAUNCH_PH(1, 2);
        chk_p1<<<2048, 256, 0, stream>>>(x, g, w_in, b_in, AQ, AK, AV, V, SG, SR, SB, FL);
        chk_p1h<<<128, 256, 0, stream>>>(x, g, w_in, b_in, lbl, Q1, K1, BMID, BLAST, FL);
        exp_attn<<<NS_ATT / 4, 256, 0, stream>>>(AQ, AK, AV, sinks, EX);
        exp_hgrn_p<<<HG_TOK, 256, 0, stream>>>(x, g, w_in, b_in, 3, 7, PS);
        LAUNCH_PH(2, 3);
        chk_attn<<<NS_ATT / 4, 256, 0, stream>>>(AQ, EX, FL);
        chk_hgrn<<<1, 512, 0, stream>>>(PS, lbl, ng, SG, 3, 7, FL);
        LAUNCH_PH(3, 4);
        chk_mg<<<64, 256, 0, stream>>>(AQ, SG, SR, SB, a.in[7], a.in[8], MG, FL);
        LAUNCH_PH(4, 5);
        chk_h1<<<64, 256, 0, stream>>>(x, MG, a.in[9], out, SSQ, FL);
        LAUNCH_PH(5, 6);
        chk_z<<<2048, 256, 0, stream>>>(out, a.in[10], a.in[11], a.in[12], (bf16*)(ws + WS_Z), FL);
        LAUNCH_PH(6, 7);
        chk_h2<<<64, 256, 0, stream>>>((bf16*)(ws + WS_XN), (bf16*)(ws + WS_Z), a.in[13], out, FL);
        exp_final<<<NS_FIN, 256, 0, stream>>>(out, a.in[14], (float*)(ws + WS_EXP_FIN));
        LAUNCH_PH(7, 8);
        chk_final<<<NS_FIN, 256, 0, stream>>>(out, (float*)(ws + WS_EXP_FIN), FL);
        report<<<1, 1, 0, stream>>>(FL, out, 2);
    }
#elif MK_N_LAUNCHES == 1
    LAUNCH_PH(0, N_PHASES);
#else
    for (int p = 0; p < N_PHASES; ++p) LAUNCH_PH(p, p + 1);
#endif
}
```

```cpp
#include <hip/hip_runtime.h>
#include <hip/hip_bf16.h>
#include <cstdio>
#include <cstdint>
#include <cmath>

namespace pg8 {
#define PG8_LAS __attribute__((address_space(3)))
typedef unsigned short bf16_t;
typedef short bf16x8 __attribute__((ext_vector_type(8)));
typedef float f32x4 __attribute__((ext_vector_type(4)));
typedef unsigned u32x4 __attribute__((ext_vector_type(4)));
constexpr int BM = 256, BK = 64, HALF = 128, HTB = HALF * BK * 2  , STAGE_BYTES = 8 * HTB, NXCD = 8, WGM = 8;

__host__ __device__ __forceinline__ int lds_byte(int r, int c) { const int st = (r >> 4) * 2 + (c >> 5), rr = r & 15, cc = c & 31, ob = rr * 64 + cc * 2; return st * 1024 + (ob ^ (((ob >> 9) & 1) << 5)); }
__host__ __device__ __forceinline__ void stage_rc(int b, int& R, int& C) { const int st = b / 1024, sb = b % 1024, swz = sb ^ (((sb >> 9) & 1) << 5); R = (st >> 1) * 16 + swz / 64; C = (st & 1) * 32 + (swz % 64) / 2; }
__host__ __device__ __forceinline__ int perm32(int rho) { const int n = rho >> 4, i = rho & 15; return 8 * (i >> 2) + 4 * n + (i & 3); }

struct Unit { int pm, pn; };
struct Gemm { const bf16_t* A; const bf16_t* Bt; int M, N, K, ld; const bf16_t* A2; const bf16_t* Bt2; int ks; };

struct StaticOrder {
    int nM, nN, nwg, G, c;
    __host__ __device__ void init(int M, int N, int G_, int c_) { nM = M / BM; nN = N / BM; nwg = nM * nN; G = G_; c = c_; }
    __host__ __device__ bool next(int i, Unit& u) const {
        const long L = (long)i * G + c; if (L >= nwg) return false;
        int wgid = (int)L; { const int q = nwg / NXCD, r = nwg % NXCD, xcd = wgid % NXCD, off = wgid / NXCD; wgid = (xcd < r ? xcd * (q + 1) : r * (q + 1) + (xcd - r) * q) + off; }
        const int nig = WGM * nN, gid = wgid / nig, fm = gid * WGM, gsz = (nM - fm) < WGM ? (nM - fm) : WGM;
        u.pm = fm + ((wgid % nig) % gsz); u.pn = (wgid % nig) / gsz; return true;
    }
    __device__ __forceinline__ void a_ready(const Unit&) const {}
    __device__ __forceinline__ void done(const Unit&) const {}
};

typedef float f32x2_t __attribute__((ext_vector_type(2))); typedef __bf16 bf16x2_t __attribute__((ext_vector_type(2)));
__device__ __forceinline__ unsigned cvt_pk_bf16(float lo, float hi) { const f32x2_t v = {lo, hi}; const bf16x2_t b = __builtin_convertvector(v, bf16x2_t); return __builtin_bit_cast(unsigned, b); }
__device__ __forceinline__ float bf_lo(unsigned w) { return __builtin_bit_cast(float, w << 16); }
__device__ __forceinline__ float bf_hi(unsigned w) { return __builtin_bit_cast(float, w & 0xffff0000u); }
constexpr float LOG2E = 1.4426950408889634f;
__device__ __forceinline__ float ex2(float x) { return __builtin_amdgcn_exp2f(x); }
__device__ __forceinline__ float rcp(float x) { return __builtin_amdgcn_rcpf(x); }
__device__ __forceinline__ float sigm(float x) { return rcp(1.f + ex2(-LOG2E * x)); }
__device__ __forceinline__ float dpp_shr(float x, int n) {
    int r;
    switch (n) { case 1: r = __builtin_amdgcn_update_dpp(0, __builtin_bit_cast(int, x), 0x111, 0xf, 0xf, true); break;
                 case 2: r = __builtin_amdgcn_update_dpp(0, __builtin_bit_cast(int, x), 0x112, 0xf, 0xf, true); break;
                 case 4: r = __builtin_amdgcn_update_dpp(0, __builtin_bit_cast(int, x), 0x114, 0xf, 0xf, true); break;
                 default: r = __builtin_amdgcn_update_dpp(0, __builtin_bit_cast(int, x), 0x118, 0xf, 0xf, true); break; }
    return __builtin_bit_cast(float, r);
}
__device__ __forceinline__ float row16_scan(float x) { x += dpp_shr(x, 1); x += dpp_shr(x, 2); x += dpp_shr(x, 4); x += dpp_shr(x, 8); return x; }

constexpr float C2 = 0.125f * LOG2E;
constexpr int IN_W = 7424;

struct EpiIn {
    static constexpr bool PERM = true, AFTER_DRAIN = false;
    bf16_t *AQ, *AK, *AV, *Q1, *K1, *V, *SG, *SR, *SB; float *BMID, *BLAST; const float *bias, *lbl;
    __device__ __forceinline__ void store8(bf16_t* p, const f32x4& v0, const f32x4& v1) const {
        u32x4 w; w.x = cvt_pk_bf16(v0[0], v0[1]); w.y = cvt_pk_bf16(v0[2], v0[3]); w.z = cvt_pk_bf16(v1[0], v1[1]); w.w = cvt_pk_bf16(v1[2], v1[3]); *(u32x4*)p = w; }
    __device__ __forceinline__ void generic(const f32x4 (&acc)[2][2][4][2], const Unit& u, int wr, int wc, int fr, int fq) const { asm volatile("" : "+v"(fr), "+v"(fq));
        const int pn = u.pn, cw = wc * 32 + 8 * fq; bf16_t* d0; bf16_t* d1; int ldc = 1024, b0, b1; bool sg = false; float sc = 1.f;
        if (pn < 4) { d0 = AQ + 256 * pn + cw; d1 = d0 + 128; b0 = 256 * pn + cw; b1 = b0 + 128; sc = C2; }
        else if (pn == 4) { ldc = 128; d0 = AK + cw; d1 = AV + cw; b0 = 1024 + cw; b1 = 1152 + cw; }
        else if (pn < 17) { const int t = pn - 13; d0 = V + 256 * t + cw; d1 = d0 + 128; b0 = 3328 + 256 * t + cw; b1 = b0 + 128; }
        else { const int t = pn - 17; d0 = SG + 256 * t + cw; d1 = d0 + 128; b0 = 4352 + 256 * t + cw; b1 = b0 + 128; sg = true; }
        const f32x4 bv00 = *(const f32x4*)(bias + b0), bv01 = *(const f32x4*)(bias + b0 + 4), bv10 = *(const f32x4*)(bias + b1), bv11 = *(const f32x4*)(bias + b1 + 4);
        const int row0 = u.pm * BM + wr * 64 + fr;
#pragma unroll
        for (int ai = 0; ai < 2; ++ai)
#pragma unroll
            for (int m = 0; m < 4; ++m) { const size_t ro = (size_t)(row0 + ai * HALF + m * 16) * ldc;
                f32x4 a0 = acc[ai][0][m][0] + bv00, a1 = acc[ai][0][m][1] + bv01, c0 = acc[ai][1][m][0] + bv10, c1 = acc[ai][1][m][1] + bv11;
                if (sg) {
#pragma unroll
                    for (int i = 0; i < 4; ++i) { a0[i] = sigm(a0[i]); a1[i] = sigm(a1[i]); c0[i] = sigm(c0[i]); c1[i] = sigm(c1[i]); } }
                else { a0 = a0 * sc; a1 = a1 * sc; c0 = c0 * sc; c1 = c1 * sc; }
                store8(d0 + ro, a0, a1); store8(d1 + ro, c0, c1); }
    }
    __device__ __forceinline__ void gates(const f32x4 (&acc)[2][2][4][2], const Unit& u, int wr, int wc, int fr, int fq) const { asm volatile("" : "+v"(fr), "+v"(fq));
        const int t = u.pn - 21, ch = 128 * t + wc * 32 + 8 * fq;
        const f32x4 ba0 = *(const f32x4*)(bias + 5376 + ch), ba1 = *(const f32x4*)(bias + 5376 + ch + 4), bb0 = *(const f32x4*)(bias + 6400 + ch), bb1 = *(const f32x4*)(bias + 6400 + ch + 4);
        const int row0 = u.pm * BM + wr * 64 + fr;
#pragma unroll
        for (int ai = 0; ai < 2; ++ai)
#pragma unroll
            for (int m = 0; m < 4; ++m) { const size_t ro = (size_t)(row0 + ai * HALF + m * 16) * 1024 + ch;
                f32x4 a0 = acc[ai][0][m][0] + ba0, a1 = acc[ai][0][m][1] + ba1, c0 = acc[ai][1][m][0] + bb0, c1 = acc[ai][1][m][1] + bb1;
#pragma unroll
                for (int i = 0; i < 4; ++i) { const float e0 = 1.f + ex2(-LOG2E * c0[i]), e1 = 1.f + ex2(-LOG2E * c1[i]);
                    a0[i] = sigm(a0[i]) * e0; a1[i] = sigm(a1[i]) * e1; c0[i] = rcp(e0); c1[i] = rcp(e1); }
                store8(SR + ro, a0, a1); store8(SB + ro, c0, c1); }
    }
    __device__ __forceinline__ void hgrn(f32x4 (&acc)[2][2][4][2], const Unit& u, int wr, int wc, int fr, int fq) const { asm volatile("" : "+v"(fr), "+v"(fq));
        const int h = u.pn - 5, ch = 128 * h + wc * 32 + 8 * fq;
        float bq[8], bf[8], lb[8], oml[8];
#pragma unroll
        for (int e = 0; e < 8; ++e) { bq[e] = bias[1280 + ch + e]; bf[e] = bias[2304 + ch + e]; lb[e] = sigm(lbl[ch + e] - lbl[1024 + ch + e]); oml[e] = 1.f - lb[e]; }
        const int row0 = u.pm * BM + wr * 64 + fr;
#pragma unroll
        for (int ai = 0; ai < 2; ++ai) {
            float carry[8], bmid[8], kk[4][8];
#pragma unroll
            for (int e = 0; e < 8; ++e) carry[e] = 0.f;
#pragma unroll
            for (int m = 0; m < 4; ++m) {
#pragma unroll
                for (int e = 0; e < 8; ++e) { const int n = e >> 2, i = e & 3;
                    const float fp = acc[ai][1][m][n][i] + bf[e], sg = sigm(fp), f = lb[e] + oml[e] * sg;
                    kk[m][e] = oml[e] * (1.f - sg);
                    float x = row16_scan(__builtin_amdgcn_logf(f)) + carry[e];
                    carry[e] = __shfl(x, 15, 16);
                    acc[ai][1][m][n][i] = x; }
                if (m == 1) {
#pragma unroll
                    for (int e = 0; e < 8; ++e) bmid[e] = carry[e]; }
            }
            const int cr = (u.pm * BM + ai * HALF + wr * 64) >> 6;
            if (fr == 15) { float* pm_ = BMID + (size_t)cr * 1024 + ch; float* pl_ = BLAST + (size_t)cr * 1024 + ch;
                *(f32x4*)pm_ = (f32x4){bmid[0], bmid[1], bmid[2], bmid[3]}; *(f32x4*)(pm_ + 4) = (f32x4){bmid[4], bmid[5], bmid[6], bmid[7]};
                *(f32x4*)pl_ = (f32x4){carry[0], carry[1], carry[2], carry[3]}; *(f32x4*)(pl_ + 4) = (f32x4){carry[4], carry[5], carry[6], carry[7]}; }
#pragma unroll
            for (int m = 0; m < 4; ++m) { const size_t ro = (size_t)(row0 + ai * HALF + m * 16) * 1024 + ch; f32x4 q0, q1, k0, k1;
#pragma unroll
                for (int e = 0; e < 8; ++e) { const int n = e >> 2, i = e & 3;
                    const float hq = acc[ai][0][m][n][i] + bq[e], eb = ex2(acc[ai][1][m][n][i] - bmid[e]);
                    const float qv = hq * sigm(hq) * eb, kv = kk[m][e] * rcp(eb);
                    if (n == 0) { q0[i] = qv; k0[i] = kv; } else { q1[i] = qv; k1[i] = kv; } }
                store8(Q1 + ro, q0, q1); store8(K1 + ro, k0, k1); }
        }
    }
    __device__ __forceinline__ void operator()(f32x4 (&acc)[2][2][4][2], const Unit& u, int wr, int wc, int fr, int fq) const { asm volatile("" : "+v"(fr), "+v"(fq));
        if (u.pn >= 5 && u.pn < 13) hgrn(acc, u, wr, wc, fr, fq);
        else if (u.pn >= 21) gates(acc, u, wr, wc, fr, fq);
        else generic(acc, u, wr, wc, fr, fq);
    }
};

struct EpiMerge {
    static constexpr bool PERM = true, AFTER_DRAIN = false;
    const bf16_t *SR, *SB; bf16_t* MG;
    __device__ __forceinline__ void scale(f32x4 (&acc)[2][2][4][2], const bf16_t* G, const Unit& u, int wr, int wc, int fr, int fq) const { asm volatile("" : "+v"(fr), "+v"(fq));
        const int col0 = u.pn * BM + wc * 32 + 8 * fq, row0 = u.pm * BM + wr * 64 + fr;
#pragma unroll
        for (int ai = 0; ai < 2; ++ai)
#pragma unroll
            for (int m = 0; m < 4; ++m)
#pragma unroll
                for (int bj = 0; bj < 2; ++bj) { const u32x4 w = *(const u32x4*)(G + (size_t)(row0 + ai * HALF + m * 16) * 1024 + col0 + bj * HALF);
                    acc[ai][bj][m][0] = acc[ai][bj][m][0] * (f32x4){bf_lo(w.x), bf_hi(w.x), bf_lo(w.y), bf_hi(w.y)};
                    acc[ai][bj][m][1] = acc[ai][bj][m][1] * (f32x4){bf_lo(w.z), bf_hi(w.z), bf_lo(w.w), bf_hi(w.w)};
                    if (bj == 1) asm volatile("" ::: "memory"); }
    }
    __device__ __forceinline__ void mid(f32x4 (&acc)[2][2][4][2], const Unit& u, int wr, int wc, int fr, int fq) const { asm volatile("" : "+v"(fr), "+v"(fq)); scale(acc, SR, u, wr, wc, fr, fq); }
    __device__ __forceinline__ void operator()(f32x4 (&acc)[2][2][4][2], const Unit& u, int wr, int wc, int fr, int fq) const { asm volatile("" : "+v"(fr), "+v"(fq));
        scale(acc, SB, u, wr, wc, fr, fq);
        const int col0 = u.pn * BM + wc * 32 + 8 * fq, row0 = u.pm * BM + wr * 64 + fr;
#pragma unroll
        for (int ai = 0; ai < 2; ++ai)
#pragma unroll
            for (int m = 0; m < 4; ++m)
#pragma unroll
                for (int bj = 0; bj < 2; ++bj) { const f32x4 v0 = acc[ai][bj][m][0], v1 = acc[ai][bj][m][1]; u32x4 w; w.x = cvt_pk_bf16(v0[0], v0[1]); w.y = cvt_pk_bf16(v0[2], v0[3]); w.z = cvt_pk_bf16(v1[0], v1[1]); w.w = cvt_pk_bf16(v1[2], v1[3]);
                    *(u32x4*)(MG + (size_t)(row0 + ai * HALF + m * 16) * 1024 + col0 + bj * HALF) = w; }
    }
};

struct EpiRes {
    static constexpr bool PERM = true, AFTER_DRAIN = false;
    const float* base; float* Hout; bf16_t* Hb; float* SSQ;
    __device__ __forceinline__ void operator()(f32x4 (&acc)[2][2][4][2], const Unit& u, int wr, int wc, int fr, int fq) const { asm volatile("" : "+v"(fr), "+v"(fq));
        const int col0 = u.pn * BM + wc * 32 + 8 * fq, row0 = u.pm * BM + wr * 64 + fr;
#pragma unroll
        for (int ai = 0; ai < 2; ++ai)
#pragma unroll
            for (int m = 0; m < 4; ++m) { const int row = row0 + ai * HALF + m * 16; const size_t ro = (size_t)row * 1024 + col0; float s = 0.f;
#pragma unroll
                for (int bj = 0; bj < 2; ++bj) { const f32x4 x0 = *(const f32x4*)(base + ro + bj * HALF), x1 = *(const f32x4*)(base + ro + bj * HALF + 4);
                    const f32x4 v0 = acc[ai][bj][m][0] + x0, v1 = acc[ai][bj][m][1] + x1;
                    *(f32x4*)(Hout + ro + bj * HALF) = v0; *(f32x4*)(Hout + ro + bj * HALF + 4) = v1;
                    if (Hb) { u32x4 w; w.x = cvt_pk_bf16(v0[0], v0[1]); w.y = cvt_pk_bf16(v0[2], v0[3]); w.z = cvt_pk_bf16(v1[0], v1[1]); w.w = cvt_pk_bf16(v1[2], v1[3]); *(u32x4*)(Hb + ro + bj * HALF) = w; }
                    s += (v0[0] * v0[0] + v0[1] * v0[1]) + (v0[2] * v0[2] + v0[3] * v0[3]) + (v1[0] * v1[0] + v1[1] * v1[1]) + (v1[2] * v1[2] + v1[3] * v1[3]); }
                s += __shfl_xor(s, 16); s += __shfl_xor(s, 32);
                if (fq == 0) SSQ[(size_t)row * 16 + 4 * u.pn + wc] = s;
                if (m & 1) asm volatile("" ::: "memory"); }
    }
};

struct EpiGU {
    static constexpr bool PERM = true, AFTER_DRAIN = false;
    const float* SSQ; bf16_t* Z;
    __device__ __forceinline__ void operator()(f32x4 (&acc)[2][2][4][2], const Unit& u, int wr, int wc, int fr, int fq) const { asm volatile("" : "+v"(fr), "+v"(fq));
        const int col0 = u.pn * 128 + wc * 32 + 8 * fq, row0 = u.pm * BM + wr * 64 + fr;
#pragma unroll
        for (int ai = 0; ai < 2; ++ai)
#pragma unroll
            for (int m = 0; m < 4; ++m) { const int row = row0 + ai * HALF + m * 16; const f32x4* sp = (const f32x4*)(SSQ + (size_t)row * 16);
                const f32x4 s0 = sp[0], s1 = sp[1], s2 = sp[2], s3 = sp[3]; const f32x4 st = (s0 + s1) + (s2 + s3);
                const float r = __builtin_amdgcn_rsqf(((st[0] + st[1]) + (st[2] + st[3])) * (1.f / 1024.f) + 1e-6f);
                f32x4 z0, z1;
#pragma unroll
                for (int i = 0; i < 4; ++i) { const float g0 = acc[ai][0][m][0][i] * r, g1 = acc[ai][0][m][1][i] * r; z0[i] = g0 * sigm(g0) * (acc[ai][1][m][0][i] * r); z1[i] = g1 * sigm(g1) * (acc[ai][1][m][1][i] * r); }
                u32x4 w; w.x = cvt_pk_bf16(z0[0], z0[1]); w.y = cvt_pk_bf16(z0[2], z0[3]); w.z = cvt_pk_bf16(z1[0], z1[1]); w.w = cvt_pk_bf16(z1[2], z1[3]);
                *(u32x4*)(Z + (size_t)row * 2816 + col0) = w; }
    }
};
template <class Epi, class Sched, bool ALIGN_EPI = false, bool SP2 = false, bool SPLIT = false>
__device__ __forceinline__ void gemm_phase(PG8_LAS unsigned char* lds, const Gemm g, const Sched& S, const Epi& E) {
    const int tid = threadIdx.x, wid = __builtin_amdgcn_readfirstlane(tid >> 6), lane = tid & 63, wr = wid >> 2, wc = wid & 3, fr = lane & 15, fq = lane >> 4;
    const int K = g.K, nt = K / BK, LD = g.ld;
    unsigned voffA[2], voffB[2];
#pragma unroll
    for (int i = 0; i < 2; ++i) { int R, C; stage_rc(tid * 16 + i * 8192, R, C); const int Rb = Epi::PERM ? ((R & ~31) + perm32(R & 31)) : R;
        voffA[i] = (unsigned)(R * LD + C) * 2u; voffB[i] = (unsigned)(Rb * LD + C) * 2u; }
    const size_t kstep = (size_t)(BK * 2);
    const size_t hstep = (size_t)HALF * LD * 2;
    const size_t tstep = 2 * hstep;
    const unsigned ldsw = (unsigned)wid * 1024u;
    const int aoff = lds_byte(wr * 64 + fr, fq * 8), boff = lds_byte(wc * 32 + fr, fq * 8);
#define PG8_SA(b, h) (((b) * 2 + (h)) * HTB)
#define PG8_SB(b, h) ((4 + (b) * 2 + (h)) * HTB)
#define PG8_STAGE(bufoff, gbase, voff) do { _Pragma("unroll") for (int _i = 0; _i < 2; ++_i) \
        __builtin_amdgcn_global_load_lds((const unsigned*)((const char*)(gbase) + (voff)[_i]), (PG8_LAS unsigned*)(lds + (bufoff) + ldsw + _i * 8192), 16, 0, 0); } while (0)
#define PG8_LDA(dst, b, h) do { _Pragma("unroll") for (int m = 0; m < 4; ++m) _Pragma("unroll") for (int k = 0; k < 2; ++k) dst[m][k] = *(const PG8_LAS bf16x8*)(lds + PG8_SA(b, h) + aoff + m * 2048 + k * 1024); } while (0)
#define PG8_LDB(dst, b, h) do { _Pragma("unroll") for (int n = 0; n < 2; ++n) _Pragma("unroll") for (int k = 0; k < 2; ++k) dst[n][k] = *(const PG8_LAS bf16x8*)(lds + PG8_SB(b, h) + boff + n * 2048 + k * 1024); } while (0)
#define PG8_MMA(ai, bj, At, Bt) do { __builtin_amdgcn_s_setprio(1); _Pragma("unroll") for (int m = 0; m < 4; ++m) _Pragma("unroll") for (int n = 0; n < 2; ++n) _Pragma("unroll") for (int k = 0; k < 2; ++k) \
        acc[ai][bj][m][n] = __builtin_amdgcn_mfma_f32_16x16x32_bf16(Bt[n][k], At[m][k], acc[ai][bj][m][n], 0, 0, 0); __builtin_amdgcn_s_setprio(0); } while (0)
#define PG8_WAIT_V(n) asm volatile("s_waitcnt vmcnt(" #n ")" ::: "memory")
#define PG8_WAIT_L(n) asm volatile("s_waitcnt lgkmcnt(" #n ")" ::: "memory")
#define PG8_BAR __builtin_amdgcn_s_barrier()
#define PG8_SCHED __builtin_amdgcn_sched_barrier(0)
    Unit cur, nxt; int ui = 0;
    if (!S.next(0, cur)) return;
    f32x4 acc[2][2][4][2];
#pragma unroll
    for (int a = 0; a < 2; ++a)
#pragma unroll
        for (int b = 0; b < 2; ++b)
#pragma unroll
            for (int m = 0; m < 4; ++m)
#pragma unroll
                for (int n = 0; n < 2; ++n) acc[a][b][m][n] = (f32x4){0.f, 0.f, 0.f, 0.f};
    bf16x8 At[4][2], B0[2][2], B1[2][2];
    const char* cA = (const char*)g.A + (size_t)cur.pm * tstep; const char* cB = (const char*)g.Bt + (size_t)cur.pn * tstep;
    const char* cA2 = cA; const char* cB2 = cB;
    if constexpr (SPLIT) { cA2 = (const char*)g.A2 + (size_t)cur.pm * tstep - (size_t)g.ks * kstep; cB2 = (const char*)g.Bt2 + (size_t)cur.pn * tstep - (size_t)g.ks * kstep; }
    S.a_ready(cur);
    if constexpr (SP2) {
        PG8_STAGE(PG8_SB(0, 0), cB, voffB); PG8_STAGE(PG8_SB(0, 1), cB + hstep, voffB); PG8_STAGE(PG8_SA(0, 0), cA, voffA); PG8_STAGE(PG8_SA(0, 1), cA + hstep, voffA);
        if (wr == 1) PG8_BAR;
        PG8_WAIT_V(2); PG8_BAR;
        PG8_STAGE(PG8_SB(1, 0), cB + kstep, voffB); PG8_STAGE(PG8_SA(1, 0), cA + kstep, voffA); PG8_STAGE(PG8_SB(1, 1), cB + hstep + kstep, voffB);
        PG8_WAIT_V(6); PG8_BAR;
    } else {
        PG8_STAGE(PG8_SB(0, 0), cB, voffB); PG8_STAGE(PG8_SA(0, 0), cA, voffA); PG8_STAGE(PG8_SB(0, 1), cB + hstep, voffB); PG8_STAGE(PG8_SA(0, 1), cA + hstep, voffA);
        if (wr == 1) PG8_BAR;
        PG8_WAIT_V(4); PG8_BAR;
        PG8_STAGE(PG8_SB(1, 0), cB + kstep, voffB); PG8_STAGE(PG8_SA(1, 0), cA + kstep, voffA); PG8_STAGE(PG8_SB(1, 1), cB + hstep + kstep, voffB);
        PG8_WAIT_V(6); PG8_BAR;
    }
    for (;;) {
        const bool has_next = S.next(ui + 1, nxt);
        const char* nA = has_next ? (const char*)g.A + (size_t)nxt.pm * tstep : cA; const char* nB = has_next ? (const char*)g.Bt + (size_t)nxt.pn * tstep : cB;
        for (int t = 0; t < nt; t += 2) {
            const bool last = (t == nt - 2);
            const char* sA = cA; const char* sA2 = cA; const char* sB2 = cB;
            if constexpr (SPLIT) { if (t >= g.ks) sA = cA2; if (t + 2 >= g.ks) { sA2 = cA2; sB2 = cB2; } if (t == g.ks) E.mid(acc, cur, wr, wc, fr, fq); }
            const char* a1 = sA + (size_t)(t + 1) * kstep;
            const char* a2 = last ? nA : sA2 + (size_t)(t + 2) * kstep; const char* b2 = last ? nB : sB2 + (size_t)(t + 2) * kstep;
            const char* a3 = a2 + kstep; const char* b3 = b2 + kstep;
            if (last && has_next) S.a_ready(nxt);
            if constexpr (SP2) {
            PG8_LDB(B0, 0, 0); PG8_LDB(B1, 0, 1); PG8_SCHED; PG8_LDA(At, 0, 0); PG8_STAGE(PG8_SA(1, 1), a1 + hstep, voffA);
            PG8_WAIT_V(8); PG8_WAIT_L(0); PG8_BAR; PG8_MMA(0, 0, At, B0); PG8_MMA(0, 1, At, B1); PG8_BAR; PG8_SCHED;
            PG8_LDA(At, 0, 1); PG8_STAGE(PG8_SB(0, 0), b2, voffB); PG8_STAGE(PG8_SB(0, 1), b2 + hstep, voffB); PG8_STAGE(PG8_SA(0, 0), a2, voffA);
            PG8_WAIT_V(8); PG8_WAIT_L(0); PG8_BAR; PG8_MMA(1, 0, At, B0); PG8_MMA(1, 1, At, B1); PG8_BAR; PG8_SCHED;
            PG8_LDB(B0, 1, 0); PG8_LDB(B1, 1, 1); PG8_SCHED; PG8_LDA(At, 1, 0); PG8_STAGE(PG8_SA(0, 1), a2 + hstep, voffA);
            PG8_WAIT_V(8); PG8_WAIT_L(0); PG8_BAR; PG8_MMA(0, 0, At, B0); PG8_MMA(0, 1, At, B1); PG8_BAR; PG8_SCHED;
            PG8_LDA(At, 1, 1); PG8_STAGE(PG8_SB(1, 0), b3, voffB); PG8_STAGE(PG8_SB(1, 1), b3 + hstep, voffB); PG8_STAGE(PG8_SA(1, 0), a3, voffA);
            PG8_WAIT_V(8); PG8_WAIT_L(0); PG8_BAR; PG8_MMA(1, 0, At, B0); PG8_MMA(1, 1, At, B1); PG8_BAR; PG8_SCHED;
            } else {
            PG8_LDB(B0, 0, 0); PG8_SCHED; PG8_LDA(At, 0, 0); PG8_STAGE(PG8_SA(1, 1), a1 + hstep, voffA);
            PG8_WAIT_L(8); PG8_BAR; PG8_WAIT_L(0); PG8_MMA(0, 0, At, B0); PG8_BAR; PG8_SCHED;
            PG8_LDB(B1, 0, 1); PG8_STAGE(PG8_SB(0, 0), b2, voffB);
            PG8_BAR; PG8_WAIT_L(0); PG8_MMA(0, 1, At, B1); PG8_BAR;
            PG8_LDA(At, 0, 1); PG8_STAGE(PG8_SA(0, 0), a2, voffA);
            PG8_BAR; PG8_WAIT_L(0); PG8_MMA(1, 0, At, B0); PG8_BAR; PG8_SCHED;
            PG8_STAGE(PG8_SB(0, 1), b2 + hstep, voffB);
            PG8_WAIT_V(6); PG8_BAR; PG8_MMA(1, 1, At, B1); PG8_BAR;
            PG8_LDB(B0, 1, 0); PG8_SCHED; PG8_LDA(At, 1, 0); PG8_STAGE(PG8_SA(0, 1), a2 + hstep, voffA);
            PG8_WAIT_L(8); PG8_BAR; PG8_WAIT_L(0); PG8_MMA(0, 0, At, B0); PG8_BAR; PG8_SCHED;
            PG8_LDB(B1, 1, 1); PG8_STAGE(PG8_SB(1, 0), b3, voffB);
            PG8_BAR; PG8_WAIT_L(0); PG8_MMA(0, 1, At, B1); PG8_BAR;
            PG8_LDA(At, 1, 1); PG8_STAGE(PG8_SA(1, 0), a3, voffA);
            PG8_BAR; PG8_WAIT_L(0); PG8_MMA(1, 0, At, B0); PG8_BAR; PG8_SCHED;
            PG8_STAGE(PG8_SB(1, 1), b3 + hstep, voffB);
            PG8_WAIT_V(6); PG8_BAR; PG8_MMA(1, 1, At, B1); PG8_BAR;
            }
        }
        if constexpr (ALIGN_EPI) { if (wr == 0) PG8_BAR; }
        if constexpr (!Epi::AFTER_DRAIN) { E(acc, cur, wr, wc, fr, fq); S.done(cur); }
        if (!has_next) break;
#pragma unroll
        for (int a = 0; a < 2; ++a)
#pragma unroll
            for (int b = 0; b < 2; ++b)
#pragma unroll
                for (int m = 0; m < 4; ++m)
#pragma unroll
                    for (int n = 0; n < 2; ++n) acc[a][b][m][n] = (f32x4){0.f, 0.f, 0.f, 0.f};
        cur = nxt; cA = nA; cB = nB; ++ui;
        if constexpr (SPLIT) { cA2 = (const char*)g.A2 + (size_t)cur.pm * tstep - (size_t)g.ks * kstep; cB2 = (const char*)g.Bt2 + (size_t)cur.pn * tstep - (size_t)g.ks * kstep; }
        if constexpr (ALIGN_EPI) { if (wr == 1) PG8_BAR; }
    }
    PG8_WAIT_V(0);
    if constexpr (!ALIGN_EPI) { if (wr == 0) PG8_BAR; }
    PG8_BAR;
    if constexpr (Epi::AFTER_DRAIN) { E.fused(acc, cur, wr, wc, fr, fq, lds, wid, lane); S.done(cur); }
#undef PG8_SA
#undef PG8_SB
#undef PG8_STAGE
#undef PG8_LDA
#undef PG8_LDB
#undef PG8_MMA
#undef PG8_WAIT_V
#undef PG8_WAIT_L
#undef PG8_BAR
#undef PG8_SCHED
}
}
#define GAS __attribute__((address_space(1)))
#define LAS __attribute__((address_space(3)))
typedef unsigned short bf16;
typedef unsigned v4u __attribute__((ext_vector_type(4)));
typedef float f32x4 __attribute__((ext_vector_type(4)));
typedef short bf16x8 __attribute__((ext_vector_type(8)));
typedef GAS unsigned gu32;
typedef GAS unsigned long long gu64;
#define RLX_AGENT __ATOMIC_RELAXED, __HIP_MEMORY_SCOPE_AGENT
#define LDS_WAIT() asm volatile("s_waitcnt lgkmcnt(0)" ::: "memory")
#define VM_WAIT() asm volatile("s_waitcnt vmcnt(0)" ::: "memory")
__device__ __forceinline__ unsigned long long rt() { return __builtin_amdgcn_s_memrealtime(); }
__device__ __forceinline__ unsigned f2bf(float f) { unsigned u = __builtin_bit_cast(unsigned, f); return (u + 0x7fffu + ((u >> 16) & 1u)) >> 16; }
__device__ __forceinline__ unsigned pk2(float lo, float hi) { return f2bf(lo) | (f2bf(hi) << 16); }

#define XB_TMO      128
#define XB_XCNT(j)  (256  + 64 * (j))
#define XB_XSUB(j)  (1280 + 64 * (j))
#define XB_XGEN(j)  (2304 + 64 * (j))
#define XB_TOP      3328
#define XB_TOPGEN   3392
#define XCD_BAR_WORDS 3456
#define XB_SPIN_CAP (1u << 18)

__device__ __forceinline__ unsigned xb_ld(unsigned* p)              { return __hip_atomic_load(p, __ATOMIC_RELAXED, __HIP_MEMORY_SCOPE_AGENT); }
__device__ __forceinline__ unsigned xb_add(unsigned* p, unsigned v) { return __hip_atomic_fetch_add(p, v, __ATOMIC_RELAXED, __HIP_MEMORY_SCOPE_AGENT); }
__device__ __forceinline__ unsigned xb_xcc_id() { return (unsigned)__builtin_amdgcn_s_getreg((3 << 11) | 20) & 0xFu; }
#define XB_SPIN(cond, bar) do { unsigned _sp = 0; while (cond) { __builtin_amdgcn_s_sleep(1); \
    if ((++_sp & 255u) == 0u) { if (xb_ld(&(bar)[XB_TMO])) break; if (_sp > XB_SPIN_CAP) { atomicAdd(&(bar)[XB_TMO], 1u); break; } } } } while (0)

struct XcdBarrier {
    unsigned* bar; unsigned x;
    volatile LAS unsigned* st;
};

__device__ __forceinline__ XcdBarrier xcd_barrier_post(unsigned* bar, volatile LAS unsigned* st) {
    XcdBarrier b; b.bar = bar; b.x = xb_xcc_id(); b.st = st;
    if (threadIdx.x == 0) (void)xb_add(&bar[XB_XCNT(b.x)], 1u);
    return b;
}
__device__ __forceinline__ void xcd_barrier_complete(unsigned* bar, unsigned x, unsigned& nloc, unsigned& nx) {
    const unsigned G = gridDim.x * gridDim.y * gridDim.z;
    unsigned sum, cnt, mine, sp = 0u;
    for (;;) {
        sum = 0u; cnt = 0u; mine = 0u;
#pragma unroll
        for (unsigned j = 0; j < 16; ++j) { const unsigned c = xb_ld(&bar[XB_XCNT(j)]); sum += c; cnt += (c > 0u) ? 1u : 0u; mine = (j == x) ? c : mine; }
        if (sum == G) break;
        __builtin_amdgcn_s_sleep(1);
        if ((++sp & 255u) == 0u) { if (xb_ld(&bar[XB_TMO])) break; if (sp > XB_SPIN_CAP) { atomicAdd(&bar[XB_TMO], 1u); break; } }
    }
    nloc = mine > 0u ? mine : 1u; nx = cnt > 0u ? cnt : 1u;
}

__device__ __forceinline__ void xcd_barrier(const XcdBarrier& b) {
    asm volatile("s_waitcnt vmcnt(0)" ::: "memory");
    __syncthreads();
    if (threadIdx.x == 0) {
        unsigned* bar = b.bar;
        __builtin_amdgcn_s_waitcnt(0);
        unsigned nloc = b.st[0], nx = b.st[1];
        if (nloc == 0u) { xcd_barrier_complete(bar, b.x, nloc, nx); b.st[0] = nloc; b.st[1] = nx; }
        const unsigned old = xb_add(&bar[XB_XSUB(b.x)], 1u);
        const unsigned gen = old / nloc;
        if (old + 1u == (gen + 1u) * nloc) {
            __builtin_amdgcn_fence(__ATOMIC_RELEASE, "agent");
            asm volatile("s_waitcnt vmcnt(0)" ::: "memory");
            const unsigned og = xb_add(&bar[XB_TOP], 1u);
            const unsigned tg = og / nx;
            if (og + 1u == (tg + 1u) * nx) xb_add(&bar[XB_TOPGEN], 1u);
            else XB_SPIN(xb_ld(&bar[XB_TOPGEN]) == tg, bar);
            __builtin_amdgcn_fence(__ATOMIC_ACQUIRE, "agent");
            xb_add(&bar[XB_XGEN(b.x)], 1u);
            asm volatile("s_waitcnt vmcnt(0)" ::: "memory");
        } else {
            XB_SPIN(xb_ld(&bar[XB_XGEN(b.x)]) == gen, bar);
            __builtin_amdgcn_fence(__ATOMIC_ACQUIRE, "agent");
            asm volatile("s_waitcnt vmcnt(0)" ::: "memory");
        }
    }
    __syncthreads();
}

constexpr int NWAVES = 8;
constexpr int BATCH = 4, SEQ = 4096, D = 1024, M = BATCH * SEQ, INW = 7424, FF = 2816, NH = 8;
constexpr float EPS = 1e-6f;
constexpr size_t MiB = 1u << 20;
constexpr size_t WS_CTL = 0, CTL_ZERO_BYTES = 1 * MiB;
constexpr size_t WS_BM = 1 * MiB, WS_BL = 2 * MiB, WS_SSQ = 3 * MiB, WS_SSQ2 = 4 * MiB;
constexpr size_t WS_WIN = 5 * MiB, WS_WBA = 20 * MiB, WS_WBH = 22 * MiB, WS_WOUT = 24 * MiB, WS_WGU = 26 * MiB, WS_WD = 37 * MiB;
constexpr size_t WS_XN = 43 * MiB;
constexpr size_t WS_L = WS_XN;
constexpr size_t WS_AQ = 75 * MiB, WS_AK = 107 * MiB, WS_AV = 111 * MiB, WS_Q1 = 115 * MiB, WS_K1 = 147 * MiB, WS_V = 179 * MiB, WS_SG = 211 * MiB, WS_END = 243 * MiB;
constexpr size_t WS_MG = WS_K1;
constexpr size_t WS_Z = WS_AQ;
static_assert(WS_WIN + (size_t)INW * D * 2 <= WS_WBA && WS_WGU + (size_t)2 * FF * D * 2 <= WS_WD && WS_WD + (size_t)D * FF * 2 <= WS_XN, "weight map");
static_assert(WS_Z + (size_t)M * FF * 2 <= WS_END, "z overlay");
constexpr int CW_TMO = 0, CW_BAR = 4096;

constexpr int RING_OFF = 0, RING_BYTES = 131072;
constexpr int LDSCTL_OFF = RING_BYTES, MISC_OFF = LDSCTL_OFF + 320;
constexpr int LDS_BYTES = 147456;

struct Frame {
    LAS unsigned char* lds;
    volatile LAS unsigned* MISC;
    gu32* ctl;
    int tid, lane, wave, vcu, G;
};

__device__ __forceinline__ int fresh_tid() { int t = threadIdx.x; asm volatile("" : "+v"(t)); return t; }
__device__ __forceinline__ float wave_sum(float v) {
#pragma unroll
    for (int o = 1; o < 64; o <<= 1) v += __shfl_xor(v, o);
    return v;
}
__device__ __forceinline__ void p0_transpose_item(const float* W, int K, int N, bf16* WT, int k0, int src_col0, int dst_row0, const float* gk, LAS float* scr, int lane) {
#pragma unroll 8
    for (int i = 0; i < 32; ++i) { const int kk = 2 * i + (lane >> 5); float w = W[(size_t)(k0 + kk) * N + src_col0 + (lane & 31)]; if (gk) w *= gk[k0 + kk]; scr[kk * 33 + (lane & 31)] = w; }
    LDS_WAIT(); asm volatile("" ::: "memory");
    const int c = lane & 7;
#pragma unroll
    for (int j = 0; j < 4; ++j) { const int n = (lane >> 3) + 8 * j; const LAS float* s = scr + (8 * c) * 33 + n;
        v4u o; o.x = pk2(s[0 * 33], s[1 * 33]); o.y = pk2(s[2 * 33], s[3 * 33]); o.z = pk2(s[4 * 33], s[5 * 33]); o.w = pk2(s[6 * 33], s[7 * 33]);
        *(GAS v4u*)(WT + (size_t)(dst_row0 + n) * K + k0 + 8 * c) = o; }
    LDS_WAIT(); asm volatile("" ::: "memory");
}
__device__ __forceinline__ int in_src_col(int vc) {
    if (vc >= 1280 && vc < 3328) { const int r = vc - 1280; return ((r >> 7) & 1 ? 2304 : 1280) + 128 * (r >> 8) + (r & 127); }
    if (vc >= 5376) { const int r = vc - 5376; return ((r >> 7) & 1 ? 6400 : 5376) + 128 * (r >> 8) + (r & 127); }
    return vc;
}
struct P0Args { const float *x, *g_mix, *w_in, *wba, *wbh, *wout, *g_ffn, *wg, *wu, *wd; bf16 *Win_t, *Wba_t, *Wbh_t, *Wout_t, *Wgu_t, *Wd_t, *XN; };
__device__ __forceinline__ void p0_prologue(Frame& F, const P0Args& a) {
    LAS float* scr = (LAS float*)(F.lds + RING_OFF + F.wave * 16384);
    const int gw = F.vcu * NWAVES + F.wave, NGW = F.G * NWAVES, lane_ = fresh_tid() & 63;
    constexpr int I_IN = (D / 64) * (INW / 32), I_SQ = (D / 64) * (D / 32), I_GU = (D / 64) * (2 * FF / 32), I_D = (FF / 64) * (D / 32);
    constexpr int NITEMS = I_IN + 3 * I_SQ + I_GU + I_D;
    for (int it = gw; it < NITEMS; it += NGW) {
        int r = it;
        if (r < I_IN) { const int nblk = INW / 32, kb = r / nblk, nb = r % nblk; p0_transpose_item(a.w_in, D, INW, a.Win_t, 64 * kb, in_src_col(32 * nb), 32 * nb, nullptr, scr, lane_); continue; } r -= I_IN;
        if (r < I_SQ) { const int nblk = D / 32, kb = r / nblk, nb = r % nblk; p0_transpose_item(a.wba, D, D, a.Wba_t, 64 * kb, 32 * nb, 32 * nb, nullptr, scr, lane_); continue; } r -= I_SQ;
        if (r < I_SQ) { const int nblk = D / 32, kb = r / nblk, nb = r % nblk; p0_transpose_item(a.wbh, D, D, a.Wbh_t, 64 * kb, 32 * nb, 32 * nb, nullptr, scr, lane_); continue; } r -= I_SQ;
        if (r < I_SQ) { const int nblk = D / 32, kb = r / nblk, nb = r % nblk; p0_transpose_item(a.wout, D, D, a.Wout_t, 64 * kb, 32 * nb, 32 * nb, nullptr, scr, lane_); continue; } r -= I_SQ;
        if (r < I_GU) { const int nblk = 2 * FF / 32, kb = r / nblk, nb = r % nblk, vc = 32 * nb, t = vc >> 8, j = (vc >> 7) & 1, i = vc & 127;
            if (j) p0_transpose_item(a.wu, D, FF, a.Wgu_t, 64 * kb, 128 * t + i, vc, a.g_ffn, scr, lane_); else p0_transpose_item(a.wg, D, FF, a.Wgu_t, 64 * kb, 128 * t + i, vc, a.g_ffn, scr, lane_);
            continue; } r -= I_GU;
        { const int nblk = D / 32, kb = r / nblk, nb = r % nblk; p0_transpose_item(a.wd, FF, D, a.Wd_t, 64 * kb, 32 * nb, 32 * nb, nullptr, scr, lane_); }
    }
    for (int m = gw; m < M; m += NGW) {
        const GAS f32x4* xr = (const GAS f32x4*)(a.x + (size_t)m * D) + lane_; const GAS f32x4* gr = (const GAS f32x4*)a.g_mix + lane_;
        f32x4 v[4]; float s = 0.f;
#pragma unroll
        for (int j = 0; j < 4; ++j) { v[j] = xr[64 * j]; s += (v[j].x * v[j].x + v[j].y * v[j].y) + (v[j].z * v[j].z + v[j].w * v[j].w); }
        const float rstd = 1.f / sqrtf(wave_sum(s) * (1.f / D) + EPS);
        GAS unsigned long long* o8 = (GAS unsigned long long*)(a.XN + (size_t)m * D) + lane_;
#pragma unroll
        for (int j = 0; j < 4; ++j) { const f32x4 g = gr[64 * j]; o8[64 * j] = (unsigned long long)pk2(v[j].x * rstd * g.x, v[j].y * rstd * g.y) | ((unsigned long long)pk2(v[j].z * rstd * g.z, v[j].w * rstd * g.w) << 32); }
    }
}
__device__ __forceinline__ float bf2f(bf16 v) { return __builtin_bit_cast(float, (unsigned)v << 16); }

__device__ __forceinline__ void attn_naive(Frame& F, bf16* AQ, const bf16* AK, const bf16* AV, const float* sinks) {
    const int gw = F.vcu * NWAVES + F.wave, NGW = F.G * NWAVES, d = fresh_tid() & 63;
    for (int w = gw; w < M * 16; w += NGW) {
        const int hq = w & 15, tok = w >> 4, hkv = hq >> 3, b = tok >> 12, i = tok & 4095;
        const float q = bf2f(AQ[(size_t)tok * D + hq * 64 + d]);
        const int j0 = i - 127 < 0 ? 0 : i - 127;
        float m = sinks[hq] * pg8::LOG2E, l = 1.f, o = 0.f;
        for (int j = j0; j <= i; ++j) { const size_t kr = (size_t)(b * SEQ + j) * 128 + hkv * 64 + d;
            float s = wave_sum(q * bf2f(AK[kr]));
            const float mn = fmaxf(m, s), al = pg8::ex2(m - mn), e = pg8::ex2(s - mn);
            l = l * al + e; o = o * al + e * bf2f(AV[kr]); m = mn; }
        AQ[(size_t)tok * D + hq * 64 + d] = (bf16)pk2(o / l, 0.f);
    }
}

namespace att {
typedef float f32x16 __attribute__((ext_vector_type(16)));
typedef short s16x4 __attribute__((ext_vector_type(4)));
typedef short v4i16_t __attribute__((ext_vector_type(4)));
__device__ __forceinline__ s16x4 vtr(LAS const unsigned char* p) { return __builtin_bit_cast(s16x4, __builtin_amdgcn_ds_read_tr16_b64_v4i16((LAS v4i16_t*)p)); }
__device__ __forceinline__ bf16x8 pack8(const f32x16& v, int s) {
    v4u w; w.x = pg8::cvt_pk_bf16(v[8 * s + 0], v[8 * s + 1]); w.y = pg8::cvt_pk_bf16(v[8 * s + 2], v[8 * s + 3]); w.z = pg8::cvt_pk_bf16(v[8 * s + 4], v[8 * s + 5]); w.w = pg8::cvt_pk_bf16(v[8 * s + 6], v[8 * s + 7]);
    return __builtin_bit_cast(bf16x8, w);
}
__device__ __forceinline__ void attn_unit(LAS unsigned char* lds, int unit, bf16* AQ, const bf16* AK, const bf16* AV, const float* sinks) {
    const int tid = fresh_tid(), lane = tid & 63, r = lane & 31, h = lane >> 5, wid = __builtin_amdgcn_readfirstlane(tid >> 6);
    const int b = unit >> 6, hkv = (unit >> 5) & 1, qb = unit & 31;
    const long krow0 = (long)b * SEQ + 128 * (qb - 1);
    LAS unsigned char* Kl = lds; LAS unsigned char* Vl = lds + 32768;
#pragma unroll
    for (int i = 0; i < 4; ++i) { const int p = tid + 512 * i, key = p & 255, c = p >> 8; const bool ok = (qb > 0) || key >= 128;
        v4u kv = (v4u){0u, 0u, 0u, 0u}, vv = (v4u){0u, 0u, 0u, 0u};
        if (ok) { const size_t go = (size_t)(krow0 + key) * 128 + hkv * 64 + c * 8; kv = *(const v4u*)(AK + go); vv = *(const v4u*)(AV + go); }
        *(LAS v4u*)(Kl + c * 4096 + key * 16) = kv;
        *(LAS v4u*)(Vl + (c >> 2) * 16384 + (key >> 4) * 1024 + (key & 15) * 64 + (c & 3) * 16) = vv; }
    __syncthreads();
    const int hq = hkv * 8 + wid; const float sink2 = sinks[hq] * pg8::LOG2E;
    const int vbase = (4 * h + ((lane & 15) >> 2)) * 64 + ((lane >> 4) & 1) * 32 + (lane & 3) * 8;
    for (int qs = 0; qs < 4; ++qs) {
        const size_t tok = (size_t)b * SEQ + 128 * qb + 32 * qs + r;
        bf16* qp = AQ + tok * D + hq * 64;
        bf16x8 qf[4];
#pragma unroll
        for (int ks = 0; ks < 4; ++ks) qf[ks] = *(const bf16x8*)(qp + 16 * ks + 8 * h);
        f32x16 st[5]; float m = sink2;
#pragma unroll
        for (int t = 0; t < 5; ++t) { const int kt = qs + t; const bool live = (qb > 0) || kt >= 4;
            f32x16 a = {};
            if (live) {
#pragma unroll
                for (int ks = 0; ks < 4; ++ks) a = __builtin_amdgcn_mfma_f32_32x32x16_bf16(*(LAS const bf16x8*)(Kl + (2 * ks + h) * 4096 + (32 * kt + r) * 16), qf[ks], a, 0, 0, 0); }
#pragma unroll
            for (int g = 0; g < 16; ++g) { const int kj = (g & 3) + 8 * (g >> 2) + 4 * h; bool keep = live; if (t == 0) keep = keep && (kj > r); if (t == 4) keep = keep && (kj <= r);
                a[g] = keep ? a[g] : -1e30f; m = fmaxf(m, a[g]); }
            st[t] = a; }
        m = fmaxf(m, __shfl_xor(m, 32));
        float l = 0.f;
#pragma unroll
        for (int t = 0; t < 5; ++t)
#pragma unroll
            for (int g = 0; g < 16; ++g) { const float e = pg8::ex2(st[t][g] - m); st[t][g] = e; l += e; }
        l += __shfl_xor(l, 32); l += pg8::ex2(sink2 - m);
        const float rl = 1.f / l;
        f32x16 o0 = {}, o1 = {};
#pragma unroll
        for (int t = 0; t < 5; ++t) { const int kt = qs + t; const bool live = (qb > 0) || kt >= 4;
            if (live) {
#pragma unroll
                for (int s = 0; s < 2; ++s) { const bf16x8 pf = pack8(st[t], s); LAS const unsigned char* vp = Vl + (2 * kt + s) * 1024 + vbase;
                    const s16x4 l0 = vtr(vp), h0 = vtr(vp + 512), l1 = vtr(vp + 16384), h1 = vtr(vp + 16384 + 512);
                    o0 = __builtin_amdgcn_mfma_f32_32x32x16_bf16((bf16x8){l0[0], l0[1], l0[2], l0[3], h0[0], h0[1], h0[2], h0[3]}, pf, o0, 0, 0, 0);
                    o1 = __builtin_amdgcn_mfma_f32_32x32x16_bf16((bf16x8){l1[0], l1[1], l1[2], l1[3], h1[0], h1[1], h1[2], h1[3]}, pf, o1, 0, 0, 0); } } }
#pragma unroll
        for (int g = 0; g < 4; ++g) { typedef unsigned u32x2 __attribute__((ext_vector_type(2)));
            u32x2 w0, w1; w0.x = pg8::cvt_pk_bf16(o0[4 * g] * rl, o0[4 * g + 1] * rl); w0.y = pg8::cvt_pk_bf16(o0[4 * g + 2] * rl, o0[4 * g + 3] * rl);
            w1.x = pg8::cvt_pk_bf16(o1[4 * g] * rl, o1[4 * g + 1] * rl); w1.y = pg8::cvt_pk_bf16(o1[4 * g + 2] * rl, o1[4 * g + 3] * rl);
            *(u32x2*)(qp + 8 * g + 4 * h) = w0; *(u32x2*)(qp + 32 + 8 * g + 4 * h) = w1; }
    }
    __syncthreads();
}
}
__device__ __forceinline__ void hgrn_naive(Frame& F, int unit, const bf16* Q1, const bf16* K1, const bf16* V, bf16* SG, const float* BMID, const float* BLAST, const float* ng) {
    const int b = unit >> 3, h = unit & 7, tid = fresh_tid();
    LAS float* Sst = (LAS float*)(F.lds);
    LAS bf16* Qs = (LAS bf16*)(F.lds + 65536);
    LAS bf16* Ks = (LAS bf16*)(F.lds + 81920);
    LAS bf16* Vs = (LAS bf16*)(F.lds + 98304);
    LAS float* As = (LAS float*)(F.lds + 114688);
    for (int i = tid; i < 128 * 128; i += 512) Sst[i] = 0.f;
    __syncthreads();
    for (int c = 0; c < 64; ++c) {
        const size_t row0 = (size_t)b * SEQ + c * 64; const int cr = b * 64 + c;
        for (int i = tid; i < 64 * 16; i += 512) { const int r = i >> 4, ch = i & 15; const size_t go = (row0 + r) * D + h * 128 + ch * 8;
            *(LAS v4u*)(Qs + r * 128 + ch * 8) = *(const v4u*)(Q1 + go); *(LAS v4u*)(Ks + r * 128 + ch * 8) = *(const v4u*)(K1 + go); *(LAS v4u*)(Vs + r * 128 + ch * 8) = *(const v4u*)(V + go); }
        __syncthreads();
        { const int cc = tid >> 3, sg = tid & 7;
#pragma unroll
            for (int u = 0; u < 8; ++u) { const int s = sg * 8 + u; float a = 0.f;
                if (s <= cc) for (int k = 0; k < 128; ++k) a += bf2f(Qs[cc * 128 + k]) * bf2f(Ks[s * 128 + k]);
                As[cc * 64 + s] = a; } }
        __syncthreads();
        { const int cc = tid >> 3, v0 = (tid & 7) * 16; float o[16];
#pragma unroll
            for (int j = 0; j < 16; ++j) o[j] = 0.f;
            for (int s = 0; s <= cc; ++s) { const float a = As[cc * 64 + s];
#pragma unroll
                for (int j = 0; j < 16; ++j) o[j] += a * bf2f(Vs[s * 128 + v0 + j]); }
            for (int k = 0; k < 128; ++k) { const float qk = bf2f(Qs[cc * 128 + k]) * pg8::ex2(BMID[(size_t)cr * 1024 + h * 128 + k]);
#pragma unroll
                for (int j = 0; j < 16; ++j) o[j] += qk * Sst[k * 128 + v0 + j]; }
            float ss = 0.f;
#pragma unroll
            for (int j = 0; j < 16; ++j) ss += o[j] * o[j];
            ss += __shfl_xor(ss, 1); ss += __shfl_xor(ss, 2); ss += __shfl_xor(ss, 4);
            const float r = 1.f / sqrtf(ss * (1.f / 128.f) + EPS);
            bf16* gp = SG + (row0 + cc) * D + h * 128 + v0;
#pragma unroll
            for (int j = 0; j < 16; ++j) gp[j] = (bf16)pk2(o[j] * r * ng[h * 128 + v0 + j] * bf2f(gp[j]), 0.f); }
        __syncthreads();
        { const int k = tid >> 2, v0 = (tid & 3) * 32; float acc[32];
#pragma unroll
            for (int j = 0; j < 32; ++j) acc[j] = 0.f;
            for (int s = 0; s < 64; ++s) { const float kv = bf2f(Ks[s * 128 + k]);
#pragma unroll
                for (int j = 0; j < 32; ++j) acc[j] += kv * bf2f(Vs[s * 128 + v0 + j]); }
            const float bmv = BMID[(size_t)cr * 1024 + h * 128 + k], blv = BLAST[(size_t)cr * 1024 + h * 128 + k]; const float e1 = pg8::ex2(blv), e2 = pg8::ex2(blv - bmv);
#pragma unroll
            for (int j = 0; j < 32; ++j) Sst[k * 128 + v0 + j] = e1 * Sst[k * 128 + v0 + j] + e2 * acc[j]; }
        __syncthreads();
    }
}
__device__ __forceinline__ void final_norm(Frame& F, float* out, const float* SSQ2, const float* g_fin) {
    const int gw = F.vcu * NWAVES + F.wave, NGW = F.G * NWAVES, lane_ = fresh_tid() & 63;
    for (int m = gw; m < M; m += NGW) {
        const float p = lane_ < 16 ? SSQ2[(size_t)m * 16 + lane_] : 0.f; const float r = 1.f / sqrtf(wave_sum(p) * (1.f / D) + EPS);
        GAS f32x4* xr = (GAS f32x4*)(out + (size_t)m * D) + lane_; const GAS f32x4* gr = (const GAS f32x4*)g_fin + lane_;
#pragma unroll
        for (int j = 0; j < 4; ++j) { const f32x4 v = xr[64 * j], g = gr[64 * j]; xr[64 * j] = v * r * g; }
    }
}

struct Args { const float* in[15]; float* out; unsigned char* ws; int ph_lo, ph_hi; };
static_assert(sizeof(Args) == 15 * 8 + 8 + 8 + 8, "Args has no padding");
constexpr int N_PHASES = 8;

__global__ void __launch_bounds__(NWAVES * 64, 2) mk_fwd(Args args) {
    extern __shared__ __attribute__((aligned(16))) unsigned char lds[];
    Frame F;
    F.lds = (LAS unsigned char*)lds;
    F.MISC = (volatile LAS unsigned*)(F.lds + MISC_OFF);
    F.tid = threadIdx.x; F.lane = F.tid & 63; F.wave = __builtin_amdgcn_readfirstlane(F.tid >> 6);
    F.G = gridDim.x; { const int bx = blockIdx.x; F.vcu = (F.G % 8 == 0) ? (bx % 8) * (F.G / 8) + bx / 8 : bx; }
    unsigned char* ws = args.ws;
    F.ctl = (gu32*)(ws + WS_CTL);
    for (int u = F.tid; u < (LDS_BYTES - LDSCTL_OFF) / 4; u += NWAVES * 64) ((LAS unsigned*)(F.lds + LDSCTL_OFF))[u] = 0u;
    __syncthreads();
    const int lo = args.ph_lo, hi = args.ph_hi;
    XcdBarrier bar; bar.bar = (unsigned*)(F.ctl + CW_BAR); bar.x = 0; bar.st = nullptr;
    if (hi - lo > 1) bar = xcd_barrier_post((unsigned*)(F.ctl + CW_BAR), F.MISC + 8);
#define IN(k) (lo <= (k) && (k) < hi)
#define SEAM(k) do { if (IN(k) && IN((k) + 1)) xcd_barrier(bar); } while (0)
    const float* x = args.in[0]; const float* b_in = args.in[3]; const float* sinks = args.in[4]; const float* lbl = args.in[5]; const float* ng = args.in[6]; const float* g_fin = args.in[14];
    float* out = args.out;
    bf16* Win_t = (bf16*)(ws + WS_WIN); bf16* Wba_t = (bf16*)(ws + WS_WBA); bf16* Wbh_t = (bf16*)(ws + WS_WBH); bf16* Wout_t = (bf16*)(ws + WS_WOUT); bf16* Wgu_t = (bf16*)(ws + WS_WGU); bf16* Wd_t = (bf16*)(ws + WS_WD);
    bf16* XN = (bf16*)(ws + WS_XN); bf16* AQ = (bf16*)(ws + WS_AQ); bf16* AK = (bf16*)(ws + WS_AK); bf16* AV = (bf16*)(ws + WS_AV); bf16* Q1 = (bf16*)(ws + WS_Q1); bf16* K1 = (bf16*)(ws + WS_K1);
    bf16* V = (bf16*)(ws + WS_V); bf16* SG = (bf16*)(ws + WS_SG); bf16* MG = (bf16*)(ws + WS_MG); bf16* Z = (bf16*)(ws + WS_Z);
    bf16* SR = (bf16*)out; bf16* SB = SR + (size_t)M * D;
    float* BMID = (float*)(ws + WS_BM); float* BLAST = (float*)(ws + WS_BL); float* SSQ = (float*)(ws + WS_SSQ); float* SSQ2 = (float*)(ws + WS_SSQ2);

    if (IN(0)) { P0Args a{x, args.in[1], args.in[2], args.in[7], args.in[8], args.in[9], args.in[10], args.in[11], args.in[12], args.in[13], Win_t, Wba_t, Wbh_t, Wout_t, Wgu_t, Wd_t, XN}; p0_prologue(F, a); }
    SEAM(0);
    if (IN(1)) {
        pg8::Gemm g{XN, Win_t, M, INW, D, D, nullptr, nullptr, 0}; pg8::StaticOrder S; S.init(M, INW, F.G, (int)blockIdx.x);
        pg8::EpiIn E{AQ, AK, AV, Q1, K1, V, SG, SR, SB, BMID, BLAST, b_in, lbl};
        pg8::gemm_phase<pg8::EpiIn, pg8::StaticOrder, true, true, false>(F.lds + RING_OFF, g, S, E);
    }
    SEAM(1);
    if (IN(2)) {
        for (int u = F.vcu; u < 256; u += F.G) att::attn_unit(F.lds + RING_OFF, u, AQ, AK, AV, sinks);
        if (blockIdx.x < 32) hgrn_naive(F, (int)blockIdx.x, Q1, K1, V, SG, BMID, BLAST, ng);
    }
    SEAM(2);
    if (IN(3)) {
        pg8::Gemm g{AQ, Wba_t, M, D, 2 * D, D, SG, Wbh_t, D / 64}; pg8::StaticOrder S; S.init(M, D, F.G, (int)blockIdx.x);
        pg8::EpiMerge E{SR, SB, MG};
        pg8::gemm_phase<pg8::EpiMerge, pg8::StaticOrder, false, true, true>(F.lds + RING_OFF, g, S, E);
    }
    SEAM(3);
    if (IN(4)) {
        pg8::Gemm g{MG, Wout_t, M, D, D, D, nullptr, nullptr, 0}; pg8::StaticOrder S; S.init(M, D, F.G, (int)blockIdx.x);
        pg8::EpiRes E{x, out, XN, SSQ};
        pg8::gemm_phase<pg8::EpiRes, pg8::StaticOrder, false, true, false>(F.lds + RING_OFF, g, S, E);
    }
    SEAM(4);
    if (IN(5)) {
        pg8::Gemm g{XN, Wgu_t, M, 2 * FF, D, D, nullptr, nullptr, 0}; pg8::StaticOrder S; S.init(M, 2 * FF, F.G, (int)blockIdx.x);
        pg8::EpiGU E{SSQ, Z};
        pg8::gemm_phase<pg8::EpiGU, pg8::StaticOrder, true, true, false>(F.lds + RING_OFF, g, S, E);
    }
    SEAM(5);
    if (IN(6)) {
        pg8::Gemm g{Z, Wd_t, M, D, FF, FF, nullptr, nullptr, 0}; pg8::StaticOrder S; S.init(M, D, F.G, (int)blockIdx.x);
        pg8::EpiRes E{out, out, nullptr, SSQ2};
        pg8::gemm_phase<pg8::EpiRes, pg8::StaticOrder, false, true, false>(F.lds + RING_OFF, g, S, E);
    }
    SEAM(6);
    if (IN(7)) final_norm(F, out, SSQ2, g_fin);
#undef IN
#undef SEAM
}


#if defined(MK_DEBUG)
namespace dbg {
constexpr size_t WS_FLAGS = 244 * MiB, WS_EXP_ATT = 245 * MiB, WS_PSM = 246 * MiB;
constexpr int NS_ATT = 2048, HG_TOK = 1024, NS_FIN = 512;
constexpr size_t WS_EXP_FIN = 248 * MiB;
__device__ __forceinline__ void flag(float* F, int k, float e) { if (!(e >= 0.f)) e = 1e30f; atomicMax((int*)F + k, __float_as_int(e)); }
__device__ __forceinline__ float nerr(float got, float exp, float rel, float abst) { return fabsf(got - exp) / (rel * fabsf(exp) + abst); }
__device__ __forceinline__ float bsum(float v, float* red) {
    const int t = threadIdx.x; red[t] = v; __syncthreads();
    for (int o = 128; o > 0; o >>= 1) { if (t < o) red[t] += red[t + o]; __syncthreads(); }
    const float r = red[0]; __syncthreads(); return r;
}
__device__ __forceinline__ void load_u(const float* x, const float* g, int row, float* us, float* red) {
    const int t = threadIdx.x; float s = 0.f;
    for (int k = t; k < D; k += 256) { const float v = x[(size_t)row * D + k]; s += v * v; }
    const float r = rsqrtf(bsum(s, red) / D + EPS);
    for (int k = t; k < D; k += 256) us[k] = x[(size_t)row * D + k] * r * g[k];
    __syncthreads();
}
__device__ __forceinline__ float pdot(const float* us, const float* w_in, const float* b_in, int oc, float* red) {
    float s = 0.f; for (int k = threadIdx.x; k < D; k += 256) s += us[k] * w_in[(size_t)k * INW + oc];
    return bsum(s, red) + b_in[oc];
}
__device__ __forceinline__ unsigned mix(unsigned s) { unsigned h = s * 0x9E3779B1u; h ^= h >> 16; h *= 0x85EBCA6Bu; h ^= h >> 13; h *= 0xC2B2AE35u; h ^= h >> 16; return h; }
__device__ __forceinline__ float sg_(float v) { return 1.f / (1.f + __expf(-v)); }
__global__ void chk_p1(const float* x, const float* g, const float* w_in, const float* b_in, const bf16* AQ, const bf16* AK, const bf16* AV, const bf16* V, const bf16* SG, const bf16* SR, const bf16* SB, float* F) {
    __shared__ float us[1024], red[256];
    const unsigned hh_ = mix(blockIdx.x); const int row = (int)(hh_ % (unsigned)M), c = (int)((hh_ >> 14) % 1024u);
    load_u(x, g, row, us, red);
    const float aq = pdot(us, w_in, b_in, c, red), ak = pdot(us, w_in, b_in, 1024 + (c & 127), red), av = pdot(us, w_in, b_in, 1152 + (c & 127), red), hi = pdot(us, w_in, b_in, 3328 + c, red),
                hg = pdot(us, w_in, b_in, 4352 + c, red), ga = pdot(us, w_in, b_in, 5376 + c, red), gb = pdot(us, w_in, b_in, 6400 + c, red);
    if (threadIdx.x == 0) {
        float e = nerr(bf2f(AQ[(size_t)row * D + c]), aq * pg8::C2, 0.02f, 0.004f);
        e = fmaxf(e, nerr(bf2f(AK[(size_t)row * 128 + (c & 127)]), ak, 0.02f, 0.02f)); e = fmaxf(e, nerr(bf2f(AV[(size_t)row * 128 + (c & 127)]), av, 0.02f, 0.02f));
        e = fmaxf(e, nerr(bf2f(V[(size_t)row * D + c]), hi, 0.02f, 0.02f)); e = fmaxf(e, nerr(bf2f(SG[(size_t)row * D + c]), sg_(hg), 0.02f, 0.01f));
        e = fmaxf(e, nerr(bf2f(SB[(size_t)row * D + c]), sg_(gb), 0.02f, 0.01f)); e = fmaxf(e, nerr(bf2f(SR[(size_t)row * D + c]), sg_(ga) / sg_(gb), 0.03f, 0.02f));
        flag(F, 0, e); }
}
__global__ void chk_p1h(const float* x, const float* g, const float* w_in, const float* b_in, const float* lbl, const bf16* Q1, const bf16* K1, const float* BMID, const float* BLAST, float* F) {
    __shared__ float us[1024], red[256], hq[64], hf[64];
    const unsigned hh_ = mix(blockIdx.x + 77u); const int cr = (int)(hh_ % 256u), ch = (int)((hh_ >> 8) % 1024u);
    for (int r = 0; r < 64; ++r) { load_u(x, g, cr * 64 + r, us, red); const float a = pdot(us, w_in, b_in, 1280 + ch, red), b = pdot(us, w_in, b_in, 2304 + ch, red); if (threadIdx.x == 0) { hq[r] = a; hf[r] = b; } }
    __syncthreads();
    if (threadIdx.x == 0) {
        const float l0 = lbl[ch], l1 = lbl[1024 + ch], lb = 1.f / (1.f + __expf(l1 - l0));
        float cum = 0.f, e = 0.f;
        for (int r = 0; r < 64; ++r) { const float s = sg_(hf[r]), f = lb + (1.f - lb) * s; cum += log2f(f); hf[r] = cum; hq[r] = hq[r] * sg_(hq[r]); red[r] = (1.f - lb) * (1.f - s); }
        const float bm = hf[31], bl = hf[63];
        e = fmaxf(e, nerr(BMID[(size_t)cr * 1024 + ch], bm, 0.01f, 0.02f)); e = fmaxf(e, nerr(BLAST[(size_t)cr * 1024 + ch], bl, 0.01f, 0.02f));
        for (int r = 0; r < 64; ++r) { const float q1 = hq[r] * exp2f(hf[r] - bm), k1 = red[r] * exp2f(bm - hf[r]);
            e = fmaxf(e, nerr(bf2f(Q1[(size_t)(cr * 64 + r) * D + ch]), q1, 0.04f, 2e-2f * exp2f(hf[r] - bm))); e = fmaxf(e, nerr(bf2f(K1[(size_t)(cr * 64 + r) * D + ch]), k1, 0.04f, 2e-2f * exp2f(bm - hf[r]))); }
        flag(F, 1, e); }
}
__global__ void exp_attn(const bf16* AQ, const bf16* AK, const bf16* AV, const float* sinks, float* EX) {
    const int s = blockIdx.x * 4 + (threadIdx.x >> 6), d = threadIdx.x & 63; if (s >= NS_ATT) return;
    const unsigned hh_ = mix(s + 999u); const int tok = (int)(hh_ % (unsigned)M), hq = (int)((hh_ >> 14) % 16u), hkv = hq >> 3, b = tok >> 12, i = tok & 4095, j0 = i - 127 < 0 ? 0 : i - 127;
    const float q = bf2f(AQ[(size_t)tok * D + hq * 64 + d]);
    float m = sinks[hq] * pg8::LOG2E;
    for (int j = j0; j <= i; ++j) m = fmaxf(m, wave_sum(q * bf2f(AK[(size_t)(b * SEQ + j) * 128 + hkv * 64 + d])));
    float l = exp2f(sinks[hq] * pg8::LOG2E - m), o = 0.f;
    for (int j = j0; j <= i; ++j) { const float e = exp2f(wave_sum(q * bf2f(AK[(size_t)(b * SEQ + j) * 128 + hkv * 64 + d])) - m); l += e; o += e * bf2f(AV[(size_t)(b * SEQ + j) * 128 + hkv * 64 + d]); }
    EX[(size_t)s * 64 + d] = o / l;
}
__global__ void chk_attn(const bf16* YA, const float* EX, float* F) {
    const int s = blockIdx.x * 4 + (threadIdx.x >> 6), d = threadIdx.x & 63; if (s >= NS_ATT) return;
    const unsigned hh_ = mix(s + 999u); const int tok = (int)(hh_ % (unsigned)M), hq = (int)((hh_ >> 14) % 16u);
    flag(F, 2, nerr(bf2f(YA[(size_t)tok * D + hq * 64 + d]), EX[(size_t)s * 64 + d], 0.03f, 0.02f));
}
__global__ void exp_hgrn_p(const float* x, const float* g, const float* w_in, const float* b_in, int bb, int hh, float* PS) {
    __shared__ float us[1024], red[256];
    const int tok = blockIdx.x; load_u(x, g, bb * SEQ + tok, us, red);
    for (int c = 0; c < 512; ++c) { const int oc = (c < 128 ? 1280 : c < 256 ? 2304 : c < 384 ? 3328 : 4352) + hh * 128 + (c & 127); const float v = pdot(us, w_in, b_in, oc, red); if (threadIdx.x == 0) PS[(size_t)tok * 512 + c] = v; }
}
__global__ void chk_hgrn(const float* PS, const float* lbl, const float* ng, const bf16* YH, int bb, int hh, float* F) {
    __shared__ float fq[128], fk[128], ff[128], red[128], po[4][128];
    const int v = threadIdx.x & 127, kq = threadIdx.x >> 7; float S[32];
#pragma unroll
    for (int k = 0; k < 32; ++k) S[k] = 0.f;
    const float l0 = lbl[hh * 128 + v], l1 = lbl[1024 + hh * 128 + v], lb = 1.f / (1.f + __expf(l1 - l0));
    float emax = 0.f;
    for (int t = 0; t < HG_TOK; ++t) {
        const float* p = PS + (size_t)t * 512;
        if (kq == 0) { const float hq = p[v], hf = p[128 + v], s = sg_(hf); fq[v] = hq * sg_(hq); ff[v] = lb + (1.f - lb) * s; fk[v] = (1.f - lb) * (1.f - s); }
        __syncthreads();
        const float vv = p[256 + v]; float o = 0.f;
#pragma unroll
        for (int k = 0; k < 32; ++k) { S[k] = ff[kq * 32 + k] * S[k] + fk[kq * 32 + k] * vv; o += fq[kq * 32 + k] * S[k]; }
        po[kq][v] = o; __syncthreads();
        o = po[0][v] + po[1][v] + po[2][v] + po[3][v];
        if (kq == 0) red[v] = o * o;
        __syncthreads();
        for (int w = 64; w > 0; w >>= 1) { if (kq == 0 && v < w) red[v] += red[v + w]; __syncthreads(); }
        const float r = rsqrtf(red[0] / 128.f + EPS), y = o * r * ng[hh * 128 + v] * sg_(p[384 + v]);
        if (kq == 0) emax = fmaxf(emax, nerr(bf2f(YH[(size_t)(bb * SEQ + t) * D + hh * 128 + v]), y, 0.05f, 0.03f));
        __syncthreads();
    }
    if (kq == 0) flag(F, 3, emax);
}
__global__ void chk_mg(const bf16* YA, const bf16* YH, const bf16* SR, const bf16* SB, const float* wba, const float* wbh, const bf16* MG, float* F) {
    const int s = blockIdx.x * blockDim.x + threadIdx.x; const unsigned hh_ = mix(s + 31337u); const int row = (int)(hh_ % (unsigned)M), c = (int)((hh_ >> 14) % 1024u);
    float a = 0.f, b = 0.f; for (int k = 0; k < D; ++k) { a += bf2f(YA[(size_t)row * D + k]) * wba[(size_t)k * D + c]; b += bf2f(YH[(size_t)row * D + k]) * wbh[(size_t)k * D + c]; }
    const float sb = bf2f(SB[(size_t)row * D + c]), sr = bf2f(SR[(size_t)row * D + c]);
    flag(F, 4, nerr(bf2f(MG[(size_t)row * D + c]), sr * sb * a + sb * b, 0.03f, 0.02f));
}
__global__ void chk_h1(const float* x, const bf16* MG, const float* wout, const float* H1, const float* SSQ, float* F) {
    const int s = blockIdx.x * blockDim.x + threadIdx.x; const unsigned hh_ = mix(s + 31337u); const int row = (int)(hh_ % (unsigned)M), c = (int)((hh_ >> 14) % 1024u);
    float a = 0.f; for (int k = 0; k < D; ++k) a += bf2f(MG[(size_t)row * D + k]) * wout[(size_t)k * D + c];
    float e = nerr(H1[(size_t)row * D + c], x[(size_t)row * D + c] + a, 0.01f, 0.02f);
    float q = 0.f, p = 0.f; for (int k = 0; k < D; ++k) { const float v = H1[(size_t)row * D + k]; q += v * v; } for (int k = 0; k < 16; ++k) p += SSQ[(size_t)row * 16 + k];
    e = fmaxf(e, nerr(p, q, 0.001f, 0.f)); flag(F, 5, e);
}
__global__ void chk_z(const float* H1, const float* gffn, const float* wg, const float* wu, const bf16* Z, float* F) {
    __shared__ float red[256];
    const unsigned hh_ = mix(blockIdx.x + 4242u); const int row = (int)(hh_ % (unsigned)M), f = (int)((hh_ >> 14) % (unsigned)FF);
    float s = 0.f; for (int k = threadIdx.x; k < D; k += 256) { const float v = H1[(size_t)row * D + k]; s += v * v; }
    const float r = rsqrtf(bsum(s, red) / D + EPS);
    float a = 0.f, b = 0.f; for (int k = threadIdx.x; k < D; k += 256) { const float u = H1[(size_t)row * D + k] * r * gffn[k]; a += u * wg[(size_t)k * FF + f]; b += u * wu[(size_t)k * FF + f]; }
    a = bsum(a, red); b = bsum(b, red);
    if (threadIdx.x == 0) flag(F, 6, nerr(bf2f(Z[(size_t)row * FF + f]), a * sg_(a) * b, 0.04f, 0.02f));
}
__global__ void chk_h2(const bf16* H1b, const bf16* Z, const float* wd, const float* H2, float* F) {
    const int s = blockIdx.x * blockDim.x + threadIdx.x; const unsigned hh_ = mix(s + 31337u); const int row = (int)(hh_ % (unsigned)M), c = (int)((hh_ >> 14) % 1024u);
    float a = 0.f; for (int k = 0; k < FF; ++k) a += bf2f(Z[(size_t)row * FF + k]) * wd[(size_t)k * D + c];
    flag(F, 7, nerr(H2[(size_t)row * D + c], bf2f(H1b[(size_t)row * D + c]) + a, 0.02f, 0.03f));
}
__global__ void exp_final(const float* H2, const float* gfin, float* EXF) {
    __shared__ float red[256];
    const int row = (int)((blockIdx.x * 2654435761u) % (unsigned)M);
    float s = 0.f; for (int k = threadIdx.x; k < D; k += 256) { const float v = H2[(size_t)row * D + k]; s += v * v; }
    const float r = rsqrtf(bsum(s, red) / D + EPS);
    for (int k = threadIdx.x; k < D; k += 256) EXF[(size_t)blockIdx.x * D + k] = H2[(size_t)row * D + k] * r * gfin[k];
}
__global__ void chk_final(const float* OUT, const float* EXF, float* F) {
    const int row = (int)((blockIdx.x * 2654435761u) % (unsigned)M); float e = 0.f;
    for (int k = threadIdx.x; k < D; k += 256) if (!(row == 0 && k == 0)) e = fmaxf(e, nerr(OUT[(size_t)row * D + k], EXF[(size_t)blockIdx.x * D + k], 0.001f, 0.001f));
    flag(F, 8, e);
}
__global__ void cksum(const unsigned* p, size_t nwords, unsigned long long* acc) {
    unsigned long long s = 0; for (size_t i = (size_t)blockIdx.x * blockDim.x + threadIdx.x; i < nwords; i += (size_t)gridDim.x * blockDim.x) { const unsigned w = p[i]; s += (unsigned long long)w * (unsigned long long)((i & 0xffff) + 1); }
    for (int o = 32; o > 0; o >>= 1) s += __shfl_down(s, o);
    if ((threadIdx.x & 63) == 0) atomicAdd(acc, s);
}
__global__ void ckcmp(const unsigned long long* a, const unsigned long long* b, int n, float* F, int k) { bool bad = false; for (int i = 0; i < n; ++i) bad |= a[i] != b[i]; if (bad) F[k] = 2.f; }
__global__ void report(const float* F, float* out, int base) {
    int code = 0; for (int k = 0; k < 6; ++k) if (!(F[base + k] <= 1.f)) code |= 1 << k;
    out[0] = 10.f * code + 5.f;
}
}
#endif

#if defined(MK_DEBUG) && MK_DEBUG >= 3
namespace nv {
constexpr int D = 1024, INW = 7424, F = 2816;
constexpr int O_AQ = 0, O_AK = 1024, O_AV = 1152, O_HQ = 1280, O_HF = 2304, O_HI = 3328, O_HG = 4352, O_GA = 5376, O_GB = 6400;
constexpr float EPS = 1e-6f;

__global__ void k_rmsnorm(const float* __restrict__ x, const float* __restrict__ g, float* __restrict__ out) {
    const int row = blockIdx.x, t = threadIdx.x;
    const float4 v = ((const float4*)(x + (size_t)row * D))[t];
    float s = v.x * v.x + v.y * v.y + v.z * v.z + v.w * v.w;
    __shared__ float red[256];
    red[t] = s; __syncthreads();
    for (int o = 128; o > 0; o >>= 1) { if (t < o) red[t] += red[t + o]; __syncthreads(); }
    const float r = rsqrtf(red[0] / D + EPS);
    const float4 gv = ((const float4*)g)[t];
    float4 o4; o4.x = v.x * r * gv.x; o4.y = v.y * r * gv.y; o4.z = v.z * r * gv.z; o4.w = v.w * r * gv.w;
    ((float4*)(out + (size_t)row * D))[t] = o4;
}

__global__ void k_gemm(const float* __restrict__ A, int lda, const float* __restrict__ W, int ldw, const float* __restrict__ bias,
                       const float* __restrict__ res, int ldres, float* __restrict__ C, int ldc, int K) {
    __shared__ float As[16][65], Ws[16][65];
    const int t = threadIdx.x, tx = t & 15, ty = t >> 4, m0 = blockIdx.y * 64, n0 = blockIdx.x * 64;
    float acc[4][4] = {};
    for (int k0 = 0; k0 < K; k0 += 16) {
        for (int i = t; i < 64 * 16; i += 256) { const int r = i >> 4, c = i & 15; As[c][r] = A[(size_t)(m0 + r) * lda + k0 + c]; }
        for (int i = t; i < 16 * 64; i += 256) { const int r = i >> 6, c = i & 63; Ws[r][c] = W[(size_t)(k0 + r) * ldw + n0 + c]; }
        __syncthreads();
#pragma unroll
        for (int k = 0; k < 16; ++k) {
            float a[4], b[4];
#pragma unroll
            for (int i = 0; i < 4; ++i) { a[i] = As[k][ty * 4 + i]; b[i] = Ws[k][tx * 4 + i]; }
#pragma unroll
            for (int i = 0; i < 4; ++i)
#pragma unroll
                for (int j = 0; j < 4; ++j) acc[i][j] += a[i] * b[j];
        }
        __syncthreads();
    }
#pragma unroll
    for (int i = 0; i < 4; ++i)
#pragma unroll
        for (int j = 0; j < 4; ++j) {
            const int m = m0 + ty * 4 + i, n = n0 + tx * 4 + j;
            float v = acc[i][j]; if (bias) v += bias[n]; if (res) v += res[(size_t)m * ldres + n];
            C[(size_t)m * ldc + n] = v;
        }
}

__global__ void k_attn(const float* __restrict__ p, const float* __restrict__ sinks, float* __restrict__ y, int S) {
    const int w = (blockIdx.x * blockDim.x + threadIdx.x) >> 6, d = threadIdx.x & 63;
    const int hq = w & 15, i = w >> 4, hkv = hq >> 3;
    const float q = p[(size_t)i * INW + O_AQ + hq * 64 + d];
    const int j0 = i - 127 < 0 ? 0 : i - 127;
    float m = sinks[hq], l = 1.f, o = 0.f;
    for (int j = j0; j <= i; ++j) {
        float s = q * p[(size_t)j * INW + O_AK + hkv * 64 + d];
#pragma unroll
        for (int x = 1; x < 64; x <<= 1) s += __shfl_xor(s, x);
        s *= 0.125f;
        const float mn = fmaxf(m, s), a = __expf(m - mn), e = __expf(s - mn);
        l = l * a + e; o = o * a + e * p[(size_t)j * INW + O_AV + hkv * 64 + d]; m = mn;
    }
    y[(size_t)i * D + hq * 64 + d] = o / l;
}

__global__ void k_hgrn(const float* __restrict__ p, const float* __restrict__ lbl, const float* __restrict__ ng, float* __restrict__ o_raw, int S) {
    const int h = blockIdx.x >> 3, vs = blockIdx.x & 7, t = threadIdx.x, kq = t >> 4, v = t & 15;
    __shared__ float part[16][17];
    float lb[8], st[8];
#pragma unroll
    for (int i = 0; i < 8; ++i) { const int ch = h * 128 + kq * 8 + i; const float l0 = lbl[ch], l1 = lbl[1024 + ch]; const float mx = fmaxf(l0, l1); const float e0 = __expf(l0 - mx), e1 = __expf(l1 - mx); lb[i] = e0 / (e0 + e1); st[i] = 0.f; }
    for (int tok = 0; tok < S; ++tok) {
        const float* row = p + (size_t)tok * INW;
        const float vv = row[O_HI + h * 128 + vs * 16 + v];
        float po = 0.f;
#pragma unroll
        for (int i = 0; i < 8; ++i) { const int ch = h * 128 + kq * 8 + i; const float fp = row[O_HF + ch], hq = row[O_HQ + ch];
            const float sg = 1.f / (1.f + __expf(-fp)); const float f = lb[i] + (1.f - lb[i]) * sg; const float kk = (1.f - lb[i]) * (1.f - sg); const float q = hq / (1.f + __expf(-hq));
            st[i] = f * st[i] + kk * vv; po += q * st[i]; }
        part[kq][v] = po; __syncthreads();
        if (t < 16) { float s = 0.f;
#pragma unroll
            for (int i = 0; i < 16; ++i) s += part[i][t];
            o_raw[(size_t)tok * D + h * 128 + vs * 16 + t] = s; }
        __syncthreads();
    }
}
__global__ void k_hgrn_post(const float* __restrict__ o_raw, const float* __restrict__ p, const float* __restrict__ ng, float* __restrict__ y) {
    const int tok = blockIdx.x >> 3, h = blockIdx.x & 7, t = threadIdx.x;
    const float o = o_raw[(size_t)tok * D + h * 128 + t];
    __shared__ float red[128]; red[t] = o * o; __syncthreads();
    for (int s = 64; s > 0; s >>= 1) { if (t < s) red[t] += red[t + s]; __syncthreads(); }
    const float r = rsqrtf(red[0] / 128.f + EPS); const float hg = p[(size_t)tok * INW + O_HG + h * 128 + t];
    y[(size_t)tok * D + h * 128 + t] = o * r * ng[h * 128 + t] / (1.f + __expf(-hg));
}
__global__ void k_merge(const float* __restrict__ p, const float* __restrict__ ya, const float* __restrict__ yb, float* __restrict__ mg) {
    const int idx = blockIdx.x * blockDim.x + threadIdx.x; const int tok = idx >> 10, c = idx & 1023;
    const float ga = p[(size_t)tok * INW + O_GA + c], gb = p[(size_t)tok * INW + O_GB + c];
    mg[idx] = ya[idx] / (1.f + __expf(-ga)) + yb[idx] / (1.f + __expf(-gb));
}
__global__ void k_swiglu(const float* __restrict__ g, const float* __restrict__ u, float* __restrict__ z, int n) {
    const int idx = blockIdx.x * blockDim.x + threadIdx.x; if (idx < n) { const float a = g[idx]; z[idx] = a / (1.f + __expf(-a)) * u[idx]; }
}
}
namespace dbg3 {
using dbg::flag; using dbg::nerr; using dbg::sg_;
constexpr int SR_ = 128;
__global__ void cmp_p1(const float* p, const float* lbl, const bf16* AQ, const bf16* AK, const bf16* AV, const bf16* Q1, const bf16* K1, const bf16* V, const bf16* SG, const bf16* SR, const bf16* SB, const float* BMID, const float* BLAST, float* F) {
    const int idx = blockIdx.x * blockDim.x + threadIdx.x, row = idx >> 10, c = idx & 1023; const float* pr = p + (size_t)row * nv::INW;
    flag(F, 0, nerr(bf2f(AQ[(size_t)row * D + c]), pr[c] * pg8::C2, 0.02f, 0.004f));
    if (c < 128) { flag(F, 0, nerr(bf2f(AK[(size_t)row * 128 + c]), pr[1024 + c], 0.02f, 0.02f)); flag(F, 0, nerr(bf2f(AV[(size_t)row * 128 + c]), pr[1152 + c], 0.02f, 0.02f)); }
    flag(F, 1, nerr(bf2f(V[(size_t)row * D + c]), pr[3328 + c], 0.02f, 0.02f)); flag(F, 1, nerr(bf2f(SG[(size_t)row * D + c]), sg_(pr[4352 + c]), 0.03f, 0.02f));
    flag(F, 2, nerr(bf2f(SB[(size_t)row * D + c]), sg_(pr[6400 + c]), 0.03f, 0.02f)); flag(F, 2, nerr(bf2f(SR[(size_t)row * D + c]), sg_(pr[5376 + c]) / sg_(pr[6400 + c]), 0.05f, 0.03f));
    const int ck = row >> 6, r0 = ck * 64; const float l0 = lbl[c], l1 = lbl[1024 + c], lb = 1.f / (1.f + __expf(l1 - l0));
    float cum = 0.f, bm = 0.f, bl = 0.f, brow = 0.f;
    for (int r = r0; r < r0 + 64; ++r) { const float s = sg_(p[(size_t)r * nv::INW + 2304 + c]); cum += log2f(lb + (1.f - lb) * s); if (r == row) brow = cum; if (r == r0 + 31) bm = cum; if (r == r0 + 63) bl = cum; }
    const float hq = pr[1280 + c], s = sg_(pr[2304 + c]);
    flag(F, 3, nerr(bf2f(Q1[(size_t)row * D + c]), hq * sg_(hq) * exp2f(brow - bm), 0.04f, 2e-2f * exp2f(brow - bm)));
    flag(F, 3, nerr(bf2f(K1[(size_t)row * D + c]), (1.f - lb) * (1.f - s) * exp2f(bm - brow), 0.04f, 2e-2f * exp2f(bm - brow)));
    flag(F, 3, nerr(BMID[(size_t)ck * 1024 + c], bm, 0.01f, 0.03f)); flag(F, 3, nerr(BLAST[(size_t)ck * 1024 + c], bl, 0.01f, 0.03f));
}
__global__ void cmp_bf(const bf16* got, const float* exp, int ld_exp, float rel, float abst, float* F, int k) {
    const int idx = blockIdx.x * blockDim.x + threadIdx.x, row = idx >> 10, c = idx & 1023; flag(F, k, nerr(bf2f(got[(size_t)row * D + c]), exp[(size_t)row * ld_exp + c], rel, abst));
}
__global__ void cmp_f32(const float* got, const float* exp, float rel, float abst, float* F, int k) {
    const int idx = blockIdx.x * blockDim.x + threadIdx.x; if (idx == 0) return; flag(F, k, nerr(got[idx], exp[idx], rel, abst));
}
__global__ void cmp_z(const bf16* got, const float* exp, float* F, int k, int n) {
    const int idx = blockIdx.x * blockDim.x + threadIdx.x; if (idx < n) flag(F, k, nerr(bf2f(got[idx]), exp[idx], 0.04f, 0.03f));
}
}
#endif

#if defined(MK_DEBUG) && MK_DEBUG == 4
namespace dbg4 {
__global__ void cmp_rows(const float* got, const float* exp, int row0, unsigned* ST) {
    __shared__ int cnt; if (threadIdx.x == 0) cnt = 0; __syncthreads();
    const int row = blockIdx.x; int bad = 0;
    for (int k = threadIdx.x; k < D; k += 256) { const float g = got[(size_t)(row0 + row) * D + k], e = exp[(size_t)row * D + k]; if (!(fabsf(g - e) <= 0.05f + 0.02f * fabsf(e))) ++bad; }
    if (bad) atomicAdd(&cnt, bad); __syncthreads();
    if (threadIdx.x == 0 && cnt > 0) { atomicAdd(ST + 0, 1u); atomicMin(ST + 1, (unsigned)(row0 + row)); atomicMax(ST + 2, (unsigned)(row0 + row)); atomicAdd(ST + 5, (unsigned)cnt); if (((row0 + row) & 15) == 15) atomicAdd(ST + 6, 1u); if (((row0 + row) & 63) == 63) atomicAdd(ST + 7, 1u); if (((row0 + row) & 15) == 0) atomicAdd(ST + 8, 1u); if (row0 + row >= 15360) atomicAdd(ST + 9, 1u); if (((row0 + row) & 4095) >= 3840) atomicAdd(ST + 10, 1u); if (((row0 + row) & 4095) < 256) atomicAdd(ST + 11, 1u); if ((row0 + row) & 1) atomicAdd(ST + 12, 1u); if ((row0 + row) & 8) atomicAdd(ST + 13, 1u); if (((row0 + row) & 127) < 8) atomicAdd(ST + 14, 1u); if (((row0 + row) & 63) < 8) atomicAdd(ST + 15, 1u); atomicMin(ST + 16, (unsigned)((row0 + row) & 127)); atomicMax(ST + 17, (unsigned)((row0 + row) & 127)); atomicMin(ST + 18, (unsigned)((row0 + row) & 2047)); atomicMax(ST + 19, (unsigned)((row0 + row) & 2047)); }
}
__global__ void cmp_cols(const float* got, const float* exp, int row0, int nrows, unsigned* ST) {
    const unsigned fr = ST[1]; if (fr < (unsigned)row0 || fr >= (unsigned)(row0 + nrows)) return;
    for (int k = threadIdx.x; k < D; k += 256) { const float g = got[(size_t)fr * D + k], e = exp[(size_t)(fr - row0) * D + k]; if (!(fabsf(g - e) <= 0.05f + 0.02f * fabsf(e))) { atomicAdd(ST + 3, 1u); atomicMin(ST + 4, (unsigned)k); } }
}
__global__ void report4(const unsigned* ST, float* out, int sel) { out[0] = 5.f + 10.f * (float)(sel == 5 ? ST[5] / 1024u : ST[sel]); }
}
#endif

#if defined(MK_DEBUG) && MK_DEBUG == 5
namespace dbg5 {
__global__ void nancount(const unsigned* p, size_t nwords, int f32mode, unsigned* CNT, int slot) {
    unsigned c = 0;
    for (size_t i = (size_t)blockIdx.x * blockDim.x + threadIdx.x; i < nwords; i += (size_t)gridDim.x * blockDim.x) { const unsigned w = p[i];
        if (f32mode == 1) { if ((w & 0x7f800000u) == 0x7f800000u) ++c; } else if (f32mode == 0) { if ((w & 0x7f80u) == 0x7f80u) ++c; if ((w & 0x7f800000u) == 0x7f800000u) ++c; }
        else { const float lo = __builtin_bit_cast(float, w << 16), hi = __builtin_bit_cast(float, w & 0xffff0000u); const bool b0 = !(fabsf(lo) <= 16.f), b1 = !(fabsf(hi) <= 16.f); if (b0) ++c; if (b1) ++c; if (b0 || b1) { const size_t e = 2 * i; if ((e & 1023) >= 896) atomicAdd(CNT + 20 + slot, 1u); atomicMin(CNT + 30 + slot, (unsigned)(e >> 10)); atomicMax(CNT + 40 + slot, (unsigned)(e >> 10)); atomicMin(CNT + 50 + slot, (unsigned)(e & 1023)); atomicMax(CNT + 60 + slot, (unsigned)(e & 1023)); const float mx = fmaxf(b0 ? fabsf(lo) : 0.f, b1 ? fabsf(hi) : 0.f); atomicMax(CNT + 70 + slot, (unsigned)fminf(mx, 1e6f)); atomicMin(CNT + 80 + slot, (unsigned)fminf(mx, 1e6f)); if (e >= 8) { const unsigned pw = p[i - 4]; if (!(fabsf(__builtin_bit_cast(float, pw << 16)) <= 16.f)) atomicAdd(CNT + 90 + slot, 1u); } } } }
    if (c) atomicAdd(CNT + slot, c);
}
__global__ void report5(const unsigned* CNT, float* out, int sel) {
    if (sel < 0) { int first = 0; for (int k = 0; k < 16; ++k) if (CNT[k] && !first) first = k + 1; out[0] = 5.f + 10.f * first; }
    else out[0] = 5.f + 10.f * (float)(CNT[sel] > 4000000u ? 4000000u : CNT[sel]);
}
}
#endif
#ifndef MK_N_LAUNCHES
#define MK_N_LAUNCHES 1
#endif
extern "C" void kernel_launch(void* const* d_in, const int* in_sizes, int n_in, void* d_out, int out_size, void* d_ws, size_t ws_size, hipStream_t stream) {
    static int grid = 0;
    if (grid == 0) {
        if (n_in != 15 || in_sizes[0] != M * D || out_size != M * D || ws_size < WS_END) { fprintf(stderr, "kernel_launch: unexpected shapes (n_in %d, in0 %d, out %d, ws %zu); nothing launched\n", n_in, n_in > 0 ? in_sizes[0] : -1, out_size, ws_size); grid = -1; return; }
        int dev = 0, cus = 0, per_cu = 0;
        if (hipGetDevice(&dev) != hipSuccess || hipDeviceGetAttribute(&cus, hipDeviceAttributeMultiprocessorCount, dev) != hipSuccess) { grid = -1; return; }
        if (hipFuncSetAttribute((const void*)mk_fwd, hipFuncAttributeMaxDynamicSharedMemorySize, LDS_BYTES) != hipSuccess) { fprintf(stderr, "kernel_launch: hipFuncSetAttribute failed\n"); grid = -1; return; }
        if (hipOccupancyMaxActiveBlocksPerMultiprocessor(&per_cu, (const void*)mk_fwd, NWAVES * 64, LDS_BYTES) != hipSuccess || per_cu < 1) { fprintf(stderr, "kernel_launch: occupancy query says %d blocks per CU\n", per_cu); per_cu = 1; }
        (void)hipGetLastError();
        grid = cus;
        if (grid != 256) fprintf(stderr, "kernel_launch: %d CUs (expected 256)\n", grid);
    }
    if (grid < 0) return;
    if (hipMemsetAsync((char*)d_ws + WS_CTL, 0, CTL_ZERO_BYTES, stream) != hipSuccess) return;
    Args a{};
    for (int i = 0; i < 15; ++i) a.in[i] = (const float*)d_in[i];
    a.out = (float*)d_out; a.ws = (unsigned char*)d_ws;
#define LAUNCH_PH(lo_, hi_) do { a.ph_lo = (lo_); a.ph_hi = (hi_); hipLaunchKernelGGL(mk_fwd, dim3(grid), dim3(NWAVES * 64), LDS_BYTES, stream, a); } while (0)
#if defined(MK_DEBUG) && MK_DEBUG == 5
    {
        using namespace dbg5; unsigned char* ws = (unsigned char*)d_ws; float* out = (float*)d_out;
        unsigned* CNT = (unsigned*)(ws + 250 * MiB);
        hipMemsetAsync(ws + 1 * MiB, 0xFF, 242 * MiB, stream); hipMemsetAsync(out, 0xFF, (size_t)M * D * 4, stream); hipMemsetAsync(CNT, 0, 512, stream); hipMemsetAsync(CNT + 30, 0xff, 40, stream); hipMemsetAsync(CNT + 50, 0xff, 40, stream); hipMemsetAsync(CNT + 80, 0xff, 40, stream);
#define NC(ptr, bytes, f32, slot) nancount<<<1024, 256, 0, stream>>>((const unsigned*)(ptr), (size_t)(bytes) / 4, (f32), CNT, (slot))
        LAUNCH_PH(0, 1); LAUNCH_PH(1, 2);
        NC(ws + WS_V, 32 * MiB, 2, 0); NC(ws + WS_SG, 32 * MiB, 2, 1); NC((unsigned char*)out + 32 * MiB, 32 * MiB, 2, 2); NC(ws + WS_AK, 8 * MiB, 2, 3);
        LAUNCH_PH(2, 3); NC(ws + WS_AQ, 32 * MiB, 2, 4); NC(ws + WS_SG, 32 * MiB, 2, 5);
        LAUNCH_PH(3, 4); NC(ws + WS_MG, 32 * MiB, 2, 6);
        LAUNCH_PH(4, 5); LAUNCH_PH(5, 6); LAUNCH_PH(6, 7); LAUNCH_PH(7, 8);
        report5<<<1, 1, 0, stream>>>(CNT, out, DBG3_BASE);
    }
#elif defined(MK_DEBUG) && MK_DEBUG == 4
    {
        using namespace dbg4; unsigned char* ws = (unsigned char*)d_ws; float* out = (float*)d_out; constexpr int S = SEQ;
        LAUNCH_PH(0, N_PHASES);
        float* SAVE = (float*)(ws + 180 * MiB); unsigned* ST = (unsigned*)(ws + 250 * MiB);
        hipMemcpyAsync(SAVE, out, (size_t)M * D * 4, hipMemcpyDeviceToDevice, stream);
        hipMemsetAsync(ST, 0, 128, stream); hipMemsetAsync(ST + 1, 0xff, 4, stream); hipMemsetAsync(ST + 4, 0xff, 4, stream); hipMemsetAsync(ST + 16, 0xff, 4, stream); hipMemsetAsync(ST + 18, 0xff, 4, stream);
        const float* x = a.in[0]; const size_t SD = (size_t)S * D; float* w = (float*)ws;
        float* U = w; float* P = U + SD; float* YAT = P + (size_t)S * nv::INW; float* YHG = YAT + SD; float* ORAW = YHG + SD;
        for (int b = 0; b < BATCH; ++b) {
            const float* xb = x + (size_t)b * SD;
            nv::k_rmsnorm<<<S, 256, 0, stream>>>(xb, a.in[1], U);
            nv::k_gemm<<<dim3(nv::INW / 64, S / 64), 256, 0, stream>>>(U, D, a.in[2], nv::INW, a.in[3], nullptr, 0, P, nv::INW, D);
            nv::k_attn<<<S * 16 / 4, 256, 0, stream>>>(P, a.in[4], YAT, S);
            nv::k_hgrn<<<64, 256, 0, stream>>>(P, a.in[5], a.in[6], ORAW, S);
            nv::k_hgrn_post<<<S * 8, 128, 0, stream>>>(ORAW, P, a.in[6], YHG);
            nv::k_gemm<<<dim3(D / 64, S / 64), 256, 0, stream>>>(YAT, D, a.in[7], D, nullptr, nullptr, 0, U, D, D);
            nv::k_gemm<<<dim3(D / 64, S / 64), 256, 0, stream>>>(YHG, D, a.in[8], D, nullptr, nullptr, 0, ORAW, D, D);
            nv::k_merge<<<S * D / 256, 256, 0, stream>>>(P, U, ORAW, YAT);
            nv::k_gemm<<<dim3(D / 64, S / 64), 256, 0, stream>>>(YAT, D, a.in[9], D, nullptr, xb, D, YHG, D, D);
            nv::k_rmsnorm<<<S, 256, 0, stream>>>(YHG, a.in[10], U);
            float* GT = P; float* UP = P + (size_t)S * nv::F; float* Z = UP + (size_t)S * nv::F;
            nv::k_gemm<<<dim3(nv::F / 64, S / 64), 256, 0, stream>>>(U, D, a.in[11], nv::F, nullptr, nullptr, 0, GT, nv::F, D);
            nv::k_gemm<<<dim3(nv::F / 64, S / 64), 256, 0, stream>>>(U, D, a.in[12], nv::F, nullptr, nullptr, 0, UP, nv::F, D);
            nv::k_swiglu<<<(S * nv::F + 255) / 256, 256, 0, stream>>>(GT, UP, Z, S * nv::F);
            nv::k_gemm<<<dim3(D / 64, S / 64), 256, 0, stream>>>(Z, nv::F, a.in[13], D, nullptr, YHG, D, ORAW, D, nv::F);
            nv::k_rmsnorm<<<S, 256, 0, stream>>>(ORAW, a.in[14], U);
            cmp_rows<<<S, 256, 0, stream>>>(SAVE, U, b * S, ST);
            cmp_cols<<<1, 256, 0, stream>>>(SAVE, U, b * S, S, ST);
        }
        report4<<<1, 1, 0, stream>>>(ST, out, DBG3_BASE);
    }
#elif defined(MK_DEBUG) && MK_DEBUG == 3
    {
        using namespace dbg3; unsigned char* ws = (unsigned char*)d_ws; float* out = (float*)d_out; constexpr int S3 = SR_;
        const float* x = a.in[0]; const float* sinks = a.in[4]; const float* lbl = a.in[5]; const float* ng = a.in[6];
        bf16* AQ = (bf16*)(ws + WS_AQ); bf16* AK = (bf16*)(ws + WS_AK); bf16* AV = (bf16*)(ws + WS_AV); bf16* Q1 = (bf16*)(ws + WS_Q1); bf16* K1 = (bf16*)(ws + WS_K1); bf16* V = (bf16*)(ws + WS_V); bf16* SG = (bf16*)(ws + WS_SG);
        bf16* MG = (bf16*)(ws + WS_MG); bf16* SR = (bf16*)out; bf16* SB = SR + (size_t)M * D; float* BMID = (float*)(ws + WS_BM); float* BLAST = (float*)(ws + WS_BL);
        float* FL = (float*)(ws + 243 * MiB); float* nb = (float*)(ws + 243 * MiB + 65536);
        float* nu = nb; float* np_ = nu + S3 * D; float* nyat = np_ + (size_t)S3 * nv::INW; float* nyhg = nyat + S3 * D; float* noraw = nyhg + S3 * D; float* nya = noraw + S3 * D; float* nyb = nya + S3 * D;
        float* nmg = nyb + S3 * D; float* nh1 = nmg + S3 * D; float* nfin = nh1 + S3 * D; float* ngt = nu; float* nup = nya; float* nz = nyat; float* nh2 = nmg;
        hipMemsetAsync(FL, 0, 256, stream);
        nv::k_rmsnorm<<<S3, 256, 0, stream>>>(x, a.in[1], nu);
        nv::k_gemm<<<dim3(nv::INW / 64, S3 / 64), 256, 0, stream>>>(nu, D, a.in[2], nv::INW, a.in[3], nullptr, 0, np_, nv::INW, D);
        nv::k_attn<<<S3 * 16 / 4, 256, 0, stream>>>(np_, sinks, nyat, S3);
        nv::k_hgrn<<<64, 256, 0, stream>>>(np_, lbl, ng, noraw, S3);
        nv::k_hgrn_post<<<S3 * 8, 128, 0, stream>>>(noraw, np_, ng, nyhg);
        nv::k_gemm<<<dim3(D / 64, S3 / 64), 256, 0, stream>>>(nyat, D, a.in[7], D, nullptr, nullptr, 0, nya, D, D);
        nv::k_gemm<<<dim3(D / 64, S3 / 64), 256, 0, stream>>>(nyhg, D, a.in[8], D, nullptr, nullptr, 0, nyb, D, D);
        nv::k_merge<<<S3 * D / 256, 256, 0, stream>>>(np_, nya, nyb, nmg);
        nv::k_gemm<<<dim3(D / 64, S3 / 64), 256, 0, stream>>>(nmg, D, a.in[9], D, nullptr, x, D, nh1, D, D);
        LAUNCH_PH(0, 1); LAUNCH_PH(1, 2);
        cmp_p1<<<S3 * 1024 / 256, 256, 0, stream>>>(np_, lbl, AQ, AK, AV, Q1, K1, V, SG, SR, SB, BMID, BLAST, FL);
        LAUNCH_PH(2, 3);
        cmp_bf<<<S3 * 1024 / 256, 256, 0, stream>>>(AQ, nyat, D, 0.03f, 0.02f, FL, 4);
        cmp_bf<<<S3 * 1024 / 256, 256, 0, stream>>>(SG, nyhg, D, 0.05f, 0.03f, FL, 5);
        LAUNCH_PH(3, 4);
        cmp_bf<<<S3 * 1024 / 256, 256, 0, stream>>>(MG, nmg, D, 0.04f, 0.03f, FL, 6);
        LAUNCH_PH(4, 5);
        cmp_f32<<<S3 * 1024 / 256, 256, 0, stream>>>(out, nh1, 0.01f, 0.03f, FL, 7);
        nv::k_rmsnorm<<<S3, 256, 0, stream>>>(nh1, a.in[10], nfin);
        nv::k_gemm<<<dim3(nv::F / 64, S3 / 64), 256, 0, stream>>>(nfin, D, a.in[11], nv::F, nullptr, nullptr, 0, ngt, nv::F, D);
        nv::k_gemm<<<dim3(nv::F / 64, S3 / 64), 256, 0, stream>>>(nfin, D, a.in[12], nv::F, nullptr, nullptr, 0, nup, nv::F, D);
        nv::k_swiglu<<<(S3 * nv::F + 255) / 256, 256, 0, stream>>>(ngt, nup, nz, S3 * nv::F);
        LAUNCH_PH(5, 6);
        cmp_z<<<(S3 * 2816 + 255) / 256, 256, 0, stream>>>((bf16*)(ws + WS_Z), nz, FL, 8, S3 * 2816);
        nv::k_gemm<<<dim3(D / 64, S3 / 64), 256, 0, stream>>>(nz, nv::F, a.in[13], D, nullptr, nh1, D, nh2, D, nv::F);
        LAUNCH_PH(6, 7);
        cmp_f32<<<S3 * 1024 / 256, 256, 0, stream>>>(out, nh2, 0.01f, 0.03f, FL, 9);
        dbg::report<<<1, 1, 0, stream>>>(FL, out, DBG3_BASE);
    }
#elif defined(MK_DEBUG) && MK_DEBUG == 2
    {
        using namespace dbg; unsigned char* ws = (unsigned char*)d_ws; float* out = (float*)d_out;
        float* FL = (float*)(ws + WS_FLAGS); unsigned long long* CK = (unsigned long long*)(ws + WS_FLAGS + 4096);
        hipMemsetAsync(FL, 0, 8192, stream);
        int slot = 0;
#define CKS(ptr, bytes) do { cksum<<<1024, 256, 0, stream>>>((const unsigned*)(ptr), (size_t)(bytes) / 4, CK + slot); ++slot; } while (0)
#define CMP(n, bit) do { ckcmp<<<1, 1, 0, stream>>>(CK + slot - 2 * (n), CK + slot - (n), (n), FL, (bit)); } while (0)
        LAUNCH_PH(0, 1); CKS(ws + WS_WIN, 70 * MiB); LAUNCH_PH(0, 1); CKS(ws + WS_WIN, 70 * MiB); CMP(1, 0);
        LAUNCH_PH(1, 2); CKS(ws + WS_AQ, 168 * MiB); CKS(out, 64 * MiB); CKS(ws + WS_BM, 2 * MiB);
        LAUNCH_PH(1, 2); CKS(ws + WS_AQ, 168 * MiB); CKS(out, 64 * MiB); CKS(ws + WS_BM, 2 * MiB); CMP(3, 1);
        LAUNCH_PH(2, 3); CKS(ws + WS_AQ, 32 * MiB); CKS(ws + WS_SG, 32 * MiB);
        LAUNCH_PH(1, 2); LAUNCH_PH(2, 3); CKS(ws + WS_AQ, 32 * MiB); CKS(ws + WS_SG, 32 * MiB); CMP(2, 2);
        LAUNCH_PH(3, 4); CKS(ws + WS_MG, 32 * MiB); LAUNCH_PH(3, 4); CKS(ws + WS_MG, 32 * MiB); CMP(1, 3);
        LAUNCH_PH(4, 5); CKS(out, 64 * MiB); CKS(ws + WS_XN, 32 * MiB); CKS(ws + WS_SSQ, 1 * MiB);
        LAUNCH_PH(4, 5); CKS(out, 64 * MiB); CKS(ws + WS_XN, 32 * MiB); CKS(ws + WS_SSQ, 1 * MiB); CMP(3, 4);
        LAUNCH_PH(5, 6); CKS(ws + WS_Z, 88 * MiB); LAUNCH_PH(5, 6); CKS(ws + WS_Z, 88 * MiB); CMP(1, 5);
        LAUNCH_PH(6, 7); LAUNCH_PH(7, 8);
        report<<<1, 1, 0, stream>>>(FL, out, 0);
    }
#elif defined(MK_DEBUG)
    {
        using namespace dbg; unsigned char* ws = (unsigned char*)d_ws; float* out = (float*)d_out;
        const float* x = a.in[0]; const float* g = a.in[1]; const float* w_in = a.in[2]; const float* b_in = a.in[3]; const float* sinks = a.in[4]; const float* lbl = a.in[5]; const float* ng = a.in[6];
        bf16* AQ = (bf16*)(ws + WS_AQ); bf16* AK = (bf16*)(ws + WS_AK); bf16* AV = (bf16*)(ws + WS_AV); bf16* Q1 = (bf16*)(ws + WS_Q1); bf16* K1 = (bf16*)(ws + WS_K1); bf16* V = (bf16*)(ws + WS_V); bf16* SG = (bf16*)(ws + WS_SG);
        bf16* MG = (bf16*)(ws + WS_MG); bf16* SR = (bf16*)out; bf16* SB = SR + (size_t)M * D; float* BMID = (float*)(ws + WS_BM); float* BLAST = (float*)(ws + WS_BL); float* SSQ = (float*)(ws + WS_SSQ);
        float* FL = (float*)(ws + WS_FLAGS); float* EX = (float*)(ws + WS_EXP_ATT); float* PS = (float*)(ws + WS_PSM);
        hipMemsetAsync(FL, 0, 256, stream);
        LAUNCH_PH(0, 1); LAUNCH_PH(1, 2);
        chk_p1<<<2048, 256, 0, stream>>>(x, g, w_in, b_in, AQ, AK, AV, V, SG, SR, SB, FL);
        chk_p1h<<<128, 256, 0, stream>>>(x, g, w_in, b_in, lbl, Q1, K1, BMID, BLAST, FL);
        exp_attn<<<NS_ATT / 4, 256, 0, stream>>>(AQ, AK, AV, sinks, EX);
        exp_hgrn_p<<<HG_TOK, 256, 0, stream>>>(x, g, w_in, b_in, 3, 7, PS);
        LAUNCH_PH(2, 3);
        chk_attn<<<NS_ATT / 4, 256, 0, stream>>>(AQ, EX, FL);
        chk_hgrn<<<1, 512, 0, stream>>>(PS, lbl, ng, SG, 3, 7, FL);
        LAUNCH_PH(3, 4);
        chk_mg<<<64, 256, 0, stream>>>(AQ, SG, SR, SB, a.in[7], a.in[8], MG, FL);
        LAUNCH_PH(4, 5);
        chk_h1<<<64, 256, 0, stream>>>(x, MG, a.in[9], out, SSQ, FL);
        LAUNCH_PH(5, 6);
        chk_z<<<2048, 256, 0, stream>>>(out, a.in[10], a.in[11], a.in[12], (bf16*)(ws + WS_Z), FL);
        LAUNCH_PH(6, 7);
        chk_h2<<<64, 256, 0, stream>>>((bf16*)(ws + WS_XN), (bf16*)(ws + WS_Z), a.in[13], out, FL);
        exp_final<<<NS_FIN, 256, 0, stream>>>(out, a.in[14], (float*)(ws + WS_EXP_FIN));
        LAUNCH_PH(7, 8);
        chk_final<<<NS_FIN, 256, 0, stream>>>(out, (float*)(ws + WS_EXP_FIN), FL);
        report<<<1, 1, 0, stream>>>(FL, out, 2);
    }
#elif MK_N_LAUNCHES == 1
    LAUNCH_PH(0, N_PHASES);
#else
    for (int p = 0; p < N_PHASES; ++p) LAUNCH_PH(p, p + 1);
#endif
}
```

```cpp
#include <hip/hip_runtime.h>
#include <hip/hip_bf16.h>
#include <cstdio>
#include <cstdint>
#include <cmath>

namespace pg8 {
#define PG8_LAS __attribute__((address_space(3)))
typedef unsigned short bf16_t;
typedef short bf16x8 __attribute__((ext_vector_type(8)));
typedef float f32x4 __attribute__((ext_vector_type(4)));
typedef unsigned u32x4 __attribute__((ext_vector_type(4)));
constexpr int BM = 256, BK = 64, HALF = 128, HTB = HALF * BK * 2  , STAGE_BYTES = 8 * HTB, NXCD = 8, WGM = 8;

__host__ __device__ __forceinline__ int lds_byte(int r, int c) { const int st = (r >> 4) * 2 + (c >> 5), rr = r & 15, cc = c & 31, ob = rr * 64 + cc * 2; return st * 1024 + (ob ^ (((ob >> 9) & 1) << 5)); }
__host__ __device__ __forceinline__ void stage_rc(int b, int& R, int& C) { const int st = b / 1024, sb = b % 1024, swz = sb ^ (((sb >> 9) & 1) << 5); R = (st >> 1) * 16 + swz / 64; C = (st & 1) * 32 + (swz % 64) / 2; }
__host__ __device__ __forceinline__ int perm32(int rho) { const int n = rho >> 4, i = rho & 15; return 8 * (i >> 2) + 4 * n + (i & 3); }

struct Unit { int pm, pn; };
struct Gemm { const bf16_t* A; const bf16_t* Bt; int M, N, K, ld; const bf16_t* A2; const bf16_t* Bt2; int ks; };

struct StaticOrder {
    int nM, nN, nwg, G, c;
    __host__ __device__ void init(int M, int N, int G_, int c_) { nM = M / BM; nN = N / BM; nwg = nM * nN; G = G_; c = c_; }
    __host__ __device__ bool next(int i, Unit& u) const {
        const long L = (long)i * G + c; if (L >= nwg) return false;
        int wgid = (int)L; { const int q = nwg / NXCD, r = nwg % NXCD, xcd = wgid % NXCD, off = wgid / NXCD; wgid = (xcd < r ? xcd * (q + 1) : r * (q + 1) + (xcd - r) * q) + off; }
        const int nig = WGM * nN, gid = wgid / nig, fm = gid * WGM, gsz = (nM - fm) < WGM ? (nM - fm) : WGM;
        u.pm = fm + ((wgid % nig) % gsz); u.pn = (wgid % nig) / gsz; return true;
    }
    __device__ __forceinline__ void a_ready(const Unit&) const {}
    __device__ __forceinline__ void done(const Unit&) const {}
};

typedef float f32x2_t __attribute__((ext_vector_type(2))); typedef __bf16 bf16x2_t __attribute__((ext_vector_type(2)));
__device__ __forceinline__ unsigned cvt_pk_bf16(float lo, float hi) { const f32x2_t v = {lo, hi}; const bf16x2_t b = __builtin_convertvector(v, bf16x2_t); return __builtin_bit_cast(unsigned, b); }
__device__ __forceinline__ float bf_lo(unsigned w) { return __builtin_bit_cast(float, w << 16); }
__device__ __forceinline__ float bf_hi(unsigned w) { return __builtin_bit_cast(float, w & 0xffff0000u); }
constexpr float LOG2E = 1.4426950408889634f;
__device__ __forceinline__ float ex2(float x) { return __builtin_amdgcn_exp2f(x); }
__device__ __forceinline__ float rcp(float x) { return __builtin_amdgcn_rcpf(x); }
__device__ __forceinline__ float sigm(float x) { return rcp(1.f + ex2(-LOG2E * x)); }
__device__ __forceinline__ float dpp_shr(float x, int n) {
    int r;
    switch (n) { case 1: r = __builtin_amdgcn_update_dpp(0, __builtin_bit_cast(int, x), 0x111, 0xf, 0xf, true); break;
                 case 2: r = __builtin_amdgcn_update_dpp(0, __builtin_bit_cast(int, x), 0x112, 0xf, 0xf, true); break;
                 case 4: r = __builtin_amdgcn_update_dpp(0, __builtin_bit_cast(int, x), 0x114, 0xf, 0xf, true); break;
                 default: r = __builtin_amdgcn_update_dpp(0, __builtin_bit_cast(int, x), 0x118, 0xf, 0xf, true); break; }
    return __builtin_bit_cast(float, r);
}
__device__ __forceinline__ float row16_scan(float x) { x += dpp_shr(x, 1); x += dpp_shr(x, 2); x += dpp_shr(x, 4); x += dpp_shr(x, 8); return x; }

constexpr float C2 = 0.125f * LOG2E;
constexpr int IN_W = 7424;

struct EpiIn {
    static constexpr bool PERM = true, AFTER_DRAIN = false;
    bf16_t *AQ, *AK, *AV, *Q1, *K1, *V, *SG, *SR, *SB; float *BMID, *BLAST; const float *bias, *lbl;
    __device__ __forceinline__ void store8(bf16_t* p, const f32x4& v0, const f32x4& v1) const {
        u32x4 w; w.x = cvt_pk_bf16(v0[0], v0[1]); w.y = cvt_pk_bf16(v0[2], v0[3]); w.z = cvt_pk_bf16(v1[0], v1[1]); w.w = cvt_pk_bf16(v1[2], v1[3]); *(u32x4*)p = w; }
    __device__ __forceinline__ void generic(const f32x4 (&acc)[2][2][4][2], const Unit& u, int wr, int wc, int fr, int fq) const { asm volatile("" : "+v"(fr), "+v"(fq));
        const int pn = u.pn, cw = wc * 32 + 8 * fq; bf16_t* d0; bf16_t* d1; int ldc = 1024, b0, b1; bool sg = false; float sc = 1.f;
        if (pn < 4) { d0 = AQ + 256 * pn + cw; d1 = d0 + 128; b0 = 256 * pn + cw; b1 = b0 + 128; sc = C2; }
        else if (pn == 4) { ldc = 128; d0 = AK + cw; d1 = AV + cw; b0 = 1024 + cw; b1 = 1152 + cw; }
        else if (pn < 17) { const int t = pn - 13; d0 = V + 256 * t + cw; d1 = d0 + 128; b0 = 3328 + 256 * t + cw; b1 = b0 + 128; }
        else { const int t = pn - 17; d0 = SG + 256 * t + cw; d1 = d0 + 128; b0 = 4352 + 256 * t + cw; b1 = b0 + 128; sg = true; }
        const f32x4 bv00 = *(const f32x4*)(bias + b0), bv01 = *(const f32x4*)(bias + b0 + 4), bv10 = *(const f32x4*)(bias + b1), bv11 = *(const f32x4*)(bias + b1 + 4);
        const int row0 = u.pm * BM + wr * 64 + fr;
#pragma unroll
        for (int ai = 0; ai < 2; ++ai)
#pragma unroll
            for (int m = 0; m < 4; ++m) { const size_t ro = (size_t)(row0 + ai * HALF + m * 16) * ldc;
                f32x4 a0 = acc[ai][0][m][0] + bv00, a1 = acc[ai][0][m][1] + bv01, c0 = acc[ai][1][m][0] + bv10, c1 = acc[ai][1][m][1] + bv11;
                if (sg) {
#pragma unroll
                    for (int i = 0; i < 4; ++i) { a0[i] = sigm(a0[i]); a1[i] = sigm(a1[i]); c0[i] = sigm(c0[i]); c1[i] = sigm(c1[i]); } }
                else { a0 = a0 * sc; a1 = a1 * sc; c0 = c0 * sc; c1 = c1 * sc; }
                store8(d0 + ro, a0, a1); store8(d1 + ro, c0, c1); }
    }
    __device__ __forceinline__ void gates(const f32x4 (&acc)[2][2][4][2], const Unit& u, int wr, int wc, int fr, int fq) const { asm volatile("" : "+v"(fr), "+v"(fq));
        const int t = u.pn - 21, ch = 128 * t + wc * 32 + 8 * fq;
        const f32x4 ba0 = *(const f32x4*)(bias + 5376 + ch), ba1 = *(const f32x4*)(bias + 5376 + ch + 4), bb0 = *(const f32x4*)(bias + 6400 + ch), bb1 = *(const f32x4*)(bias + 6400 + ch + 4);
        const int row0 = u.pm * BM + wr * 64 + fr;
#pragma unroll
        for (int ai = 0; ai < 2; ++ai)
#pragma unroll
            for (int m = 0; m < 4; ++m) { const size_t ro = (size_t)(row0 + ai * HALF + m * 16) * 1024 + ch;
                f32x4 a0 = acc[ai][0][m][0] + ba0, a1 = acc[ai][0][m][1] + ba1, c0 = acc[ai][1][m][0] + bb0, c1 = acc[ai][1][m][1] + bb1;
#pragma unroll
                for (int i = 0; i < 4; ++i) { const float e0 = 1.f + ex2(-LOG2E * c0[i]), e1 = 1.f + ex2(-LOG2E * c1[i]);
                    a0[i] = sigm(a0[i]) * e0; a1[i] = sigm(a1[i]) * e1; c0[i] = rcp(e0); c1[i] = rcp(e1); }
                store8(SR + ro, a0, a1); store8(SB + ro, c0, c1); }
    }
    __device__ __forceinline__ void hgrn(f32x4 (&acc)[2][2][4][2], const Unit& u, int wr, int wc, int fr, int fq) const { asm volatile("" : "+v"(fr), "+v"(fq));
        const int h = u.pn - 5, ch = 128 * h + wc * 32 + 8 * fq;
        float bq[8], bf[8], lb[8], oml[8];
#pragma unroll
        for (int e = 0; e < 8; ++e) { bq[e] = bias[1280 + ch + e]; bf[e] = bias[2304 + ch + e]; lb[e] = sigm(lbl[ch + e] - lbl[1024 + ch + e]); oml[e] = 1.f - lb[e]; }
        const int row0 = u.pm * BM + wr * 64 + fr;
#pragma unroll
        for (int ai = 0; ai < 2; ++ai) {
            float carry[8], bmid[8], kk[4][8];
#pragma unroll
            for (int e = 0; e < 8; ++e) carry[e] = 0.f;
#pragma unroll
            for (int m = 0; m < 4; ++m) {
#pragma unroll
                for (int e = 0; e < 8; ++e) { const int n = e >> 2, i = e & 3;
                    const float fp = acc[ai][1][m][n][i] + bf[e], sg = sigm(fp), f = lb[e] + oml[e] * sg;
                    kk[m][e] = oml[e] * (1.f - sg);
                    float x = row16_scan(__builtin_amdgcn_logf(f)) + carry[e];
                    carry[e] = __shfl(x, 15, 16);
                    acc[ai][1][m][n][i] = x; }
                if (m == 1) {
#pragma unroll
                    for (int e = 0; e < 8; ++e) bmid[e] = carry[e]; }
            }
            const int cr = (u.pm * BM + ai * HALF + wr * 64) >> 6;
            if (fr == 15) { float* pm_ = BMID + (size_t)cr * 1024 + ch; float* pl_ = BLAST + (size_t)cr * 1024 + ch;
                *(f32x4*)pm_ = (f32x4){bmid[0], bmid[1], bmid[2], bmid[3]}; *(f32x4*)(pm_ + 4) = (f32x4){bmid[4], bmid[5], bmid[6], bmid[7]};
                *(f32x4*)pl_ = (f32x4){carry[0], carry[1], carry[2], carry[3]}; *(f32x4*)(pl_ + 4) = (f32x4){carry[4], carry[5], carry[6], carry[7]}; }
#pragma unroll
            for (int m = 0; m < 4; ++m) { const size_t ro = (size_t)(row0 + ai * HALF + m * 16) * 1024 + ch; f32x4 q0, q1, k0, k1;
#pragma unroll
                for (int e = 0; e < 8; ++e) { const int n = e >> 2, i = e & 3;
                    const float hq = acc[ai][0][m][n][i] + bq[e], eb = ex2(acc[ai][1][m][n][i] - bmid[e]);
                    const float qv = hq * sigm(hq) * eb, kv = kk[m][e] * rcp(eb);
                    if (n == 0) { q0[i] = qv; k0[i] = kv; } else { q1[i] = qv; k1[i] = kv; } }
                store8(Q1 + ro, q0, q1); store8(K1 + ro, k0, k1); }
        }
    }
    __device__ __forceinline__ void operator()(f32x4 (&acc)[2][2][4][2], const Unit& u, int wr, int wc, int fr, int fq) const { asm volatile("" : "+v"(fr), "+v"(fq));
        if (u.pn >= 5 && u.pn < 13) hgrn(acc, u, wr, wc, fr, fq);
        else if (u.pn >= 21) gates(acc, u, wr, wc, fr, fq);
        else generic(acc, u, wr, wc, fr, fq);
    }
};

struct EpiMerge {
    static constexpr bool PERM = true, AFTER_DRAIN = false;
    const bf16_t *SR, *SB; bf16_t* MG;
    __device__ __forceinline__ void scale(f32x4 (&acc)[2][2][4][2], const bf16_t* G, const Unit& u, int wr, int wc, int fr, int fq) const { asm volatile("" : "+v"(fr), "+v"(fq));
        const int col0 = u.pn * BM + wc * 32 + 8 * fq, row0 = u.pm * BM + wr * 64 + fr;
#pragma unroll
        for (int ai = 0; ai < 2; ++ai)
#pragma unroll
            for (int m = 0; m < 4; ++m)
#pragma unroll
                for (int bj = 0; bj < 2; ++bj) { const u32x4 w = *(const u32x4*)(G + (size_t)(row0 + ai * HALF + m * 16) * 1024 + col0 + bj * HALF);
                    acc[ai][bj][m][0] = acc[ai][bj][m][0] * (f32x4){bf_lo(w.x), bf_hi(w.x), bf_lo(w.y), bf_hi(w.y)};
                    acc[ai][bj][m][1] = acc[ai][bj][m][1] * (f32x4){bf_lo(w.z), bf_hi(w.z), bf_lo(w.w), bf_hi(w.w)};
                    if (bj == 1) asm volatile("" ::: "memory"); }
    }
    __device__ __forceinline__ void mid(f32x4 (&acc)[2][2][4][2], const Unit& u, int wr, int wc, int fr, int fq) const { asm volatile("" : "+v"(fr), "+v"(fq)); scale(acc, SR, u, wr, wc, fr, fq); }
    __device__ __forceinline__ void operator()(f32x4 (&acc)[2][2][4][2], const Unit& u, int wr, int wc, int fr, int fq) const { asm volatile("" : "+v"(fr), "+v"(fq));
        scale(acc, SB, u, wr, wc, fr, fq);
        const int col0 = u.pn * BM + wc * 32 + 8 * fq, row0 = u.pm * BM + wr * 64 + fr;
#pragma unroll
        for (int ai = 0; ai < 2; ++ai)
#pragma unroll
            for (int m = 0; m < 4; ++m)
#pragma unroll
                for (int bj = 0; bj < 2; ++bj) { const f32x4 v0 = acc[ai][bj][m][0], v1 = acc[ai][bj][m][1]; u32x4 w; w.x = cvt_pk_bf16(v0[0], v0[1]); w.y = cvt_pk_bf16(v0[2], v0[3]); w.z = cvt_pk_bf16(v1[0], v1[1]); w.w = cvt_pk_bf16(v1[2], v1[3]);
                    *(u32x4*)(MG + (size_t)(row0 + ai * HALF + m * 16) * 1024 + col0 + bj * HALF) = w; }
    }
};

struct EpiRes {
    static constexpr bool PERM = true, AFTER_DRAIN = false;
    const float* base; float* Hout; bf16_t* Hb; float* SSQ;
    __device__ __forceinline__ void operator()(f32x4 (&acc)[2][2][4][2], const Unit& u, int wr, int wc, int fr, int fq) const { asm volatile("" : "+v"(fr), "+v"(fq));
        const int col0 = u.pn * BM + wc * 32 + 8 * fq, row0 = u.pm * BM + wr * 64 + fr;
#pragma unroll
        for (int ai = 0; ai < 2; ++ai)
#pragma unroll
            for (int m = 0; m < 4; ++m) { const int row = row0 + ai * HALF + m * 16; const size_t ro = (size_t)row * 1024 + col0; float s = 0.f;
#pragma unroll
                for (int bj = 0; bj < 2; ++bj) { const f32x4 x0 = *(const f32x4*)(base + ro + bj * HALF), x1 = *(const f32x4*)(base + ro + bj * HALF + 4);
                    const f32x4 v0 = acc[ai][bj][m][0] + x0, v1 = acc[ai][bj][m][1] + x1;
                    *(f32x4*)(Hout + ro + bj * HALF) = v0; *(f32x4*)(Hout + ro + bj * HALF + 4) = v1;
                    if (Hb) { u32x4 w; w.x = cvt_pk_bf16(v0[0], v0[1]); w.y = cvt_pk_bf16(v0[2], v0[3]); w.z = cvt_pk_bf16(v1[0], v1[1]); w.w = cvt_pk_bf16(v1[2], v1[3]); *(u32x4*)(Hb + ro + bj * HALF) = w; }
                    s += (v0[0] * v0[0] + v0[1] * v0[1]) + (v0[2] * v0[2] + v0[3] * v0[3]) + (v1[0] * v1[0] + v1[1] * v1[1]) + (v1[2] * v1[2] + v1[3] * v1[3]); }
                s += __shfl_xor(s, 16); s += __shfl_xor(s, 32);
                if (fq == 0) SSQ[(size_t)row * 16 + 4 * u.pn + wc] = s;
                if (m & 1) asm volatile("" ::: "memory"); }
    }
};

struct EpiGU {
    static constexpr bool PERM = true, AFTER_DRAIN = false;
    const float* SSQ; bf16_t* Z;
    __device__ __forceinline__ void operator()(f32x4 (&acc)[2][2][4][2], const Unit& u, int wr, int wc, int fr, int fq) const { asm volatile("" : "+v"(fr), "+v"(fq));
        const int col0 = u.pn * 128 + wc * 32 + 8 * fq, row0 = u.pm * BM + wr * 64 + fr;
#pragma unroll
        for (int ai = 0; ai < 2; ++ai)
#pragma unroll
            for (int m = 0; m < 4; ++m) { const int row = row0 + ai * HALF + m * 16; const f32x4* sp = (const f32x4*)(SSQ + (size_t)row * 16);
                const f32x4 s0 = sp[0], s1 = sp[1], s2 = sp[2], s3 = sp[3]; const f32x4 st = (s0 + s1) + (s2 + s3);
                const float r = __builtin_amdgcn_rsqf(((st[0] + st[1]) + (st[2] + st[3])) * (1.f / 1024.f) + 1e-6f);
                f32x4 z0, z1;
#pragma unroll
                for (int i = 0; i < 4; ++i) { const float g0 = acc[ai][0][m][0][i] * r, g1 = acc[ai][0][m][1][i] * r; z0[i] = g0 * sigm(g0) * (acc[ai][1][m][0][i] * r); z1[i] = g1 * sigm(g1) * (acc[ai][1][m][1][i] * r); }
                u32x4 w; w.x = cvt_pk_bf16(z0[0], z0[1]); w.y = cvt_pk_bf16(z0[2], z0[3]); w.z = cvt_pk_bf16(z1[0], z1[1]); w.w = cvt_pk_bf16(z1[2], z1[3]);
                *(u32x4*)(Z + (size_t)row * 2816 + col0) = w; }
    }
};
template <class Epi, class Sched, bool ALIGN_EPI = false, bool SP2 = false, bool SPLIT = false>
__device__ __forceinline__ void gemm_phase(PG8_LAS unsigned char* lds, const Gemm g, const Sched& S, const Epi& E) {
    const int tid = threadIdx.x, wid = __builtin_amdgcn_readfirstlane(tid >> 6), lane = tid & 63, wr = wid >> 2, wc = wid & 3, fr = lane & 15, fq = lane >> 4;
    const int K = g.K, nt = K / BK, LD = g.ld;
    unsigned voffA[2], voffB[2];
#pragma unroll
    for (int i = 0; i < 2; ++i) { int R, C; stage_rc(tid * 16 + i * 8192, R, C); const int Rb = Epi::PERM ? ((R & ~31) + perm32(R & 31)) : R;
        voffA[i] = (unsigned)(R * LD + C) * 2u; voffB[i] = (unsigned)(Rb * LD + C) * 2u; }
    const size_t kstep = (size_t)(BK * 2);
    const size_t hstep = (size_t)HALF * LD * 2;
    const size_t tstep = 2 * hstep;
    const unsigned ldsw = (unsigned)wid * 1024u;
    const int aoff = lds_byte(wr * 64 + fr, fq * 8), boff = lds_byte(wc * 32 + fr, fq * 8);
#define PG8_SA(b, h) (((b) * 2 + (h)) * HTB)
#define PG8_SB(b, h) ((4 + (b) * 2 + (h)) * HTB)
#define PG8_STAGE(bufoff, gbase, voff) do { _Pragma("unroll") for (int _i = 0; _i < 2; ++_i) \
        __builtin_amdgcn_global_load_lds((const unsigned*)((const char*)(gbase) + (voff)[_i]), (PG8_LAS unsigned*)(lds + (bufoff) + ldsw + _i * 8192), 16, 0, 0); } while (0)
#define PG8_LDA(dst, b, h) do { _Pragma("unroll") for (int m = 0; m < 4; ++m) _Pragma("unroll") for (int k = 0; k < 2; ++k) dst[m][k] = *(const PG8_LAS bf16x8*)(lds + PG8_SA(b, h) + aoff + m * 2048 + k * 1024); } while (0)
#define PG8_LDB(dst, b, h) do { _Pragma("unroll") for (int n = 0; n < 2; ++n) _Pragma("unroll") for (int k = 0; k < 2; ++k) dst[n][k] = *(const PG8_LAS bf16x8*)(lds + PG8_SB(b, h) + boff + n * 2048 + k * 1024); } while (0)
#define PG8_MMA(ai, bj, At, Bt) do { __builtin_amdgcn_s_setprio(1); _Pragma("unroll") for (int m = 0; m < 4; ++m) _Pragma("unroll") for (int n = 0; n < 2; ++n) _Pragma("unroll") for (int k = 0; k < 2; ++k) \
        acc[ai][bj][m][n] = __builtin_amdgcn_mfma_f32_16x16x32_bf16(Bt[n][k], At[m][k], acc[ai][bj][m][n], 0, 0, 0); __builtin_amdgcn_s_setprio(0); } while (0)
#define PG8_WAIT_V(n) asm volatile("s_waitcnt vmcnt(" #n ")" ::: "memory")
#define PG8_WAIT_L(n) asm volatile("s_waitcnt lgkmcnt(" #n ")" ::: "memory")
#define PG8_BAR __builtin_amdgcn_s_barrier()
#define PG8_SCHED __builtin_amdgcn_sched_barrier(0)
    Unit cur, nxt; int ui = 0;
    if (!S.next(0, cur)) return;
    f32x4 acc[2][2][4][2];
#pragma unroll
    for (int a = 0; a < 2; ++a)
#pragma unroll
        for (int b = 0; b < 2; ++b)
#pragma unroll
            for (int m = 0; m < 4; ++m)
#pragma unroll
                for (int n = 0; n < 2; ++n) acc[a][b][m][n] = (f32x4){0.f, 0.f, 0.f, 0.f};
    bf16x8 At[4][2], B0[2][2], B1[2][2];
    const char* cA = (const char*)g.A + (size_t)cur.pm * tstep; const char* cB = (const char*)g.Bt + (size_t)cur.pn * tstep;
    const char* cA2 = cA; const char* cB2 = cB;
    if constexpr (SPLIT) { cA2 = (const char*)g.A2 + (size_t)cur.pm * tstep - (size_t)g.ks * kstep; cB2 = (const char*)g.Bt2 + (size_t)cur.pn * tstep - (size_t)g.ks * kstep; }
    S.a_ready(cur);
    if constexpr (SP2) {
        PG8_STAGE(PG8_SB(0, 0), cB, voffB); PG8_STAGE(PG8_SB(0, 1), cB + hstep, voffB); PG8_STAGE(PG8_SA(0, 0), cA, voffA); PG8_STAGE(PG8_SA(0, 1), cA + hstep, voffA);
        if (wr == 1) PG8_BAR;
        PG8_WAIT_V(2); PG8_BAR;
        PG8_STAGE(PG8_SB(1, 0), cB + kstep, voffB); PG8_STAGE(PG8_SA(1, 0), cA + kstep, voffA); PG8_STAGE(PG8_SB(1, 1), cB + hstep + kstep, voffB);
        PG8_WAIT_V(6); PG8_BAR;
    } else {
        PG8_STAGE(PG8_SB(0, 0), cB, voffB); PG8_STAGE(PG8_SA(0, 0), cA, voffA); PG8_STAGE(PG8_SB(0, 1), cB + hstep, voffB); PG8_STAGE(PG8_SA(0, 1), cA + hstep, voffA);
        if (wr == 1) PG8_BAR;
        PG8_WAIT_V(4); PG8_BAR;
        PG8_STAGE(PG8_SB(1, 0), cB + kstep, voffB); PG8_STAGE(PG8_SA(1, 0), cA + kstep, voffA); PG8_STAGE(PG8_SB(1, 1), cB + hstep + kstep, voffB);
        PG8_WAIT_V(6); PG8_BAR;
    }
    for (;;) {
        const bool has_next = S.next(ui + 1, nxt);
        const char* nA = has_next ? (const char*)g.A + (size_t)nxt.pm * tstep : cA; const char* nB = has_next ? (const char*)g.Bt + (size_t)nxt.pn * tstep : cB;
        for (int t = 0; t < nt; t += 2) {
            const bool last = (t == nt - 2);
            const char* sA = cA; const char* sA2 = cA; const char* sB2 = cB;
            if constexpr (SPLIT) { if (t >= g.ks) sA = cA2; if (t + 2 >= g.ks) { sA2 = cA2; sB2 = cB2; } if (t == g.ks) E.mid(acc, cur, wr, wc, fr, fq); }
            const char* a1 = sA + (size_t)(t + 1) * kstep;
            const char* a2 = last ? nA : sA2 + (size_t)(t + 2) * kstep; const char* b2 = last ? nB : sB2 + (size_t)(t + 2) * kstep;
            const char* a3 = a2 + kstep; const char* b3 = b2 + kstep;
            if (last && has_next) S.a_ready(nxt);
            if constexpr (SP2) {
            PG8_LDB(B0, 0, 0); PG8_LDB(B1, 0, 1); PG8_SCHED; PG8_LDA(At, 0, 0); PG8_STAGE(PG8_SA(1, 1), a1 + hstep, voffA);
            PG8_WAIT_V(8); PG8_WAIT_L(0); PG8_BAR; PG8_MMA(0, 0, At, B0); PG8_MMA(0, 1, At, B1); PG8_BAR; PG8_SCHED;
            PG8_LDA(At, 0, 1); PG8_STAGE(PG8_SB(0, 0), b2, voffB); PG8_STAGE(PG8_SB(0, 1), b2 + hstep, voffB); PG8_STAGE(PG8_SA(0, 0), a2, voffA);
            PG8_WAIT_V(8); PG8_WAIT_L(0); PG8_BAR; PG8_MMA(1, 0, At, B0); PG8_MMA(1, 1, At, B1); PG8_BAR; PG8_SCHED;
            PG8_LDB(B0, 1, 0); PG8_LDB(B1, 1, 1); PG8_SCHED; PG8_LDA(At, 1, 0); PG8_STAGE(PG8_SA(0, 1), a2 + hstep, voffA);
            PG8_WAIT_V(8); PG8_WAIT_L(0); PG8_BAR; PG8_MMA(0, 0, At, B0); PG8_MMA(0, 1, At, B1); PG8_BAR; PG8_SCHED;
            PG8_LDA(At, 1, 1); PG8_STAGE(PG8_SB(1, 0), b3, voffB); PG8_STAGE(PG8_SB(1, 1), b3 + hstep, voffB); PG8_STAGE(PG8_SA(1, 0), a3, voffA);
            PG8_WAIT_V(8); PG8_WAIT_L(0); PG8_BAR; PG8_MMA(1, 0, At, B0); PG8_MMA(1, 1, At, B1); PG8_BAR; PG8_SCHED;
            } else {
            PG8_LDB(B0, 0, 0); PG8_SCHED; PG8_LDA(At, 0, 0); PG8_STAGE(PG8_SA(1, 1), a1 + hstep, voffA);
            PG8_WAIT_L(8); PG8_BAR; PG8_WAIT_L(0); PG8_MMA(0, 0, At, B0); PG8_BAR; PG8_SCHED;
            PG8_LDB(B1, 0, 1); PG8_STAGE(PG8_SB(0, 0), b2, voffB);
            PG8_BAR; PG8_WAIT_L(0); PG8_MMA(0, 1, At, B1); PG8_BAR;
            PG8_LDA(At, 0, 1); PG8_STAGE(PG8_SA(0, 0), a2, voffA);
            PG8_BAR; PG8_WAIT_L(0); PG8_MMA(1, 0, At, B0); PG8_BAR; PG8_SCHED;
            PG8_STAGE(PG8_SB(0, 1), b2 + hstep, voffB);
            PG8_WAIT_V(6); PG8_BAR; PG8_MMA(1, 1, At, B1); PG8_BAR;
            PG8_LDB(B0, 1, 0); PG8_SCHED; PG8_LDA(At, 1, 0); PG8_STAGE(PG8_SA(0, 1), a2 + hstep, voffA);
            PG8_WAIT_L(8); PG8_BAR; PG8_WAIT_L(0); PG8_MMA(0, 0, At, B0); PG8_BAR; PG8_SCHED;
            PG8_LDB(B1, 1, 1); PG8_STAGE(PG8_SB(1, 0), b3, voffB);
            PG8_BAR; PG8_WAIT_L(0); PG8_MMA(0, 1, At, B1); PG8_BAR;
            PG8_LDA(At, 1, 1); PG8_STAGE(PG8_SA(1, 0), a3, voffA);
            PG8_BAR; PG8_WAIT_L(0); PG8_MMA(1, 0, At, B0); PG8_BAR; PG8_SCHED;
            PG8_STAGE(PG8_SB(1, 1), b3 + hstep, voffB);
            PG8_WAIT_V(6); PG8_BAR; PG8_MMA(1, 1, At, B1); PG8_BAR;
            }
        }
        if constexpr (ALIGN_EPI) { if (wr == 0) PG8_BAR; }
        if constexpr (!Epi::AFTER_DRAIN) { E(acc, cur, wr, wc, fr, fq); S.done(cur); }
        if (!has_next) break;
#pragma unroll
        for (int a = 0; a < 2; ++a)
#pragma unroll
            for (int b = 0; b < 2; ++b)
#pragma unroll
                for (int m = 0; m < 4; ++m)
#pragma unroll
                    for (int n = 0; n < 2; ++n) acc[a][b][m][n] = (f32x4){0.f, 0.f, 0.f, 0.f};
        cur = nxt; cA = nA; cB = nB; ++ui;
        if constexpr (SPLIT) { cA2 = (const char*)g.A2 + (size_t)cur.pm * tstep - (size_t)g.ks * kstep; cB2 = (const char*)g.Bt2 + (size_t)cur.pn * tstep - (size_t)g.ks * kstep; }
        if constexpr (ALIGN_EPI) { if (wr == 1) PG8_BAR; }
    }
    PG8_WAIT_V(0);
    if constexpr (!ALIGN_EPI) { if (wr == 0) PG8_BAR; }
    PG8_BAR;
    if constexpr (Epi::AFTER_DRAIN) { E.fused(acc, cur, wr, wc, fr, fq, lds, wid, lane); S.done(cur); }
#undef PG8_SA
#undef PG8_SB
#undef PG8_STAGE
#undef PG8_LDA
#undef PG8_LDB
#undef PG8_MMA
#undef PG8_WAIT_V
#undef PG8_WAIT_L
#undef PG8_BAR
#undef PG8_SCHED
}
}
#define GAS __attribute__((address_space(1)))
#define LAS __attribute__((address_space(3)))
typedef unsigned short bf16;
typedef unsigned v4u __attribute__((ext_vector_type(4)));
typedef float f32x4 __attribute__((ext_vector_type(4)));
typedef short bf16x8 __attribute__((ext_vector_type(8)));
typedef GAS unsigned gu32;
typedef GAS unsigned long long gu64;
#define RLX_AGENT __ATOMIC_RELAXED, __HIP_MEMORY_SCOPE_AGENT
#define LDS_WAIT() asm volatile("s_waitcnt lgkmcnt(0)" ::: "memory")
#define VM_WAIT() asm volatile("s_waitcnt vmcnt(0)" ::: "memory")
__device__ __forceinline__ unsigned long long rt() { return __builtin_amdgcn_s_memrealtime(); }
__device__ __forceinline__ unsigned f2bf(float f) { unsigned u = __builtin_bit_cast(unsigned, f); return (u + 0x7fffu + ((u >> 16) & 1u)) >> 16; }
__device__ __forceinline__ unsigned pk2(float lo, float hi) { return f2bf(lo) | (f2bf(hi) << 16); }

#define XB_TMO      128
#define XB_XCNT(j)  (256  + 64 * (j))
#define XB_XSUB(j)  (1280 + 64 * (j))
#define XB_XGEN(j)  (2304 + 64 * (j))
#define XB_TOP      3328
#define XB_TOPGEN   3392
#define XCD_BAR_WORDS 3456
#define XB_SPIN_CAP (1u << 18)

__device__ __forceinline__ unsigned xb_ld(unsigned* p)              { return __hip_atomic_load(p, __ATOMIC_RELAXED, __HIP_MEMORY_SCOPE_AGENT); }
__device__ __forceinline__ unsigned xb_add(unsigned* p, unsigned v) { return __hip_atomic_fetch_add(p, v, __ATOMIC_RELAXED, __HIP_MEMORY_SCOPE_AGENT); }
__device__ __forceinline__ unsigned xb_xcc_id() { return (unsigned)__builtin_amdgcn_s_getreg((3 << 11) | 20) & 0xFu; }
#define XB_SPIN(cond, bar) do { unsigned _sp = 0; while (cond) { __builtin_amdgcn_s_sleep(1); \
    if ((++_sp & 255u) == 0u) { if (xb_ld(&(bar)[XB_TMO])) break; if (_sp > XB_SPIN_CAP) { atomicAdd(&(bar)[XB_TMO], 1u); break; } } } } while (0)

struct XcdBarrier {
    unsigned* bar; unsigned x;
    volatile LAS unsigned* st;
};

__device__ __forceinline__ XcdBarrier xcd_barrier_post(unsigned* bar, volatile LAS unsigned* st) {
    XcdBarrier b; b.bar = bar; b.x = xb_xcc_id(); b.st = st;
    if (threadIdx.x == 0) (void)xb_add(&bar[XB_XCNT(b.x)], 1u);
    return b;
}
__device__ __forceinline__ void xcd_barrier_complete(unsigned* bar, unsigned x, unsigned& nloc, unsigned& nx) {
    const unsigned G = gridDim.x * gridDim.y * gridDim.z;
    unsigned sum, cnt, mine, sp = 0u;
    for (;;) {
        sum = 0u; cnt = 0u; mine = 0u;
#pragma unroll
        for (unsigned j = 0; j < 16; ++j) { const unsigned c = xb_ld(&bar[XB_XCNT(j)]); sum += c; cnt += (c > 0u) ? 1u : 0u; mine = (j == x) ? c : mine; }
        if (sum == G) break;
        __builtin_amdgcn_s_sleep(1);
        if ((++sp & 255u) == 0u) { if (xb_ld(&bar[XB_TMO])) break; if (sp > XB_SPIN_CAP) { atomicAdd(&bar[XB_TMO], 1u); break; } }
    }
    nloc = mine > 0u ? mine : 1u; nx = cnt > 0u ? cnt : 1u;
}

__device__ __forceinline__ void xcd_barrier(const XcdBarrier& b) {
    asm volatile("s_waitcnt vmcnt(0)" ::: "memory");
    __syncthreads();
    if (threadIdx.x == 0) {
        unsigned* bar = b.bar;
        __builtin_amdgcn_s_waitcnt(0);
        unsigned nloc = b.st[0], nx = b.st[1];
        if (nloc == 0u) { xcd_barrier_complete(bar, b.x, nloc, nx); b.st[0] = nloc; b.st[1] = nx; }
        const unsigned old = xb_add(&bar[XB_XSUB(b.x)], 1u);
        const unsigned gen = old / nloc;
        if (old + 1u == (gen + 1u) * nloc) {
            __builtin_amdgcn_fence(__ATOMIC_RELEASE, "agent");
            asm volatile("s_waitcnt vmcnt(0)" ::: "memory");
            const unsigned og = xb_add(&bar[XB_TOP], 1u);
            const unsigned tg = og / nx;
            if (og + 1u == (tg + 1u) * nx) xb_add(&bar[XB_TOPGEN], 1u);
            else XB_SPIN(xb_ld(&bar[XB_TOPGEN]) == tg, bar);
            __builtin_amdgcn_fence(__ATOMIC_ACQUIRE, "agent");
            xb_add(&bar[XB_XGEN(b.x)], 1u);
            asm volatile("s_waitcnt vmcnt(0)" ::: "memory");
        } else {
            XB_SPIN(xb_ld(&bar[XB_XGEN(b.x)]) == gen, bar);
            __builtin_amdgcn_fence(__ATOMIC_ACQUIRE, "agent");
            asm volatile("s_waitcnt vmcnt(0)" ::: "memory");
        }
    }
    __syncthreads();
}

constexpr int NWAVES = 8;
constexpr int BATCH = 4, SEQ = 4096, D = 1024, M = BATCH * SEQ, INW = 7424, FF = 2816, NH = 8;
constexpr float EPS = 1e-6f;
constexpr size_t MiB = 1u << 20;
constexpr size_t WS_CTL = 0, CTL_ZERO_BYTES = 1 * MiB;
constexpr size_t WS_BM = 1 * MiB, WS_BL = 2 * MiB, WS_SSQ = 3 * MiB, WS_SSQ2 = 4 * MiB;
constexpr size_t WS_WIN = 5 * MiB, WS_WBA = 20 * MiB, WS_WBH = 22 * MiB, WS_WOUT = 24 * MiB, WS_WGU = 26 * MiB, WS_WD = 37 * MiB;
constexpr size_t WS_XN = 43 * MiB;
constexpr size_t WS_L = WS_XN;
constexpr size_t WS_AQ = 75 * MiB, WS_AK = 107 * MiB, WS_AV = 111 * MiB, WS_Q1 = 115 * MiB, WS_K1 = 147 * MiB, WS_V = 179 * MiB, WS_SG = 211 * MiB, WS_END = 243 * MiB;
constexpr size_t WS_MG = WS_K1;
constexpr size_t WS_Z = WS_AQ;
static_assert(WS_WIN + (size_t)INW * D * 2 <= WS_WBA && WS_WGU + (size_t)2 * FF * D * 2 <= WS_WD && WS_WD + (size_t)D * FF * 2 <= WS_XN, "weight map");
static_assert(WS_Z + (size_t)M * FF * 2 <= WS_END, "z overlay");
constexpr int CW_TMO = 0, CW_BAR = 4096;

constexpr int RING_OFF = 0, RING_BYTES = 131072;
constexpr int LDSCTL_OFF = RING_BYTES, MISC_OFF = LDSCTL_OFF + 320;
constexpr int LDS_BYTES = 147456;

struct Frame {
    LAS unsigned char* lds;
    volatile LAS unsigned* MISC;
    gu32* ctl;
    int tid, lane, wave, vcu, G;
};

__device__ __forceinline__ int fresh_tid() { int t = threadIdx.x; asm volatile("" : "+v"(t)); return t; }
__device__ __forceinline__ float wave_sum(float v) {
#pragma unroll
    for (int o = 1; o < 64; o <<= 1) v += __shfl_xor(v, o);
    return v;
}
__device__ __forceinline__ void p0_transpose_item(const float* W, int K, int N, bf16* WT, int k0, int src_col0, int dst_row0, const float* gk, LAS float* scr, int lane) {
#pragma unroll 8
    for (int i = 0; i < 32; ++i) { const int kk = 2 * i + (lane >> 5); float w = W[(size_t)(k0 + kk) * N + src_col0 + (lane & 31)]; if (gk) w *= gk[k0 + kk]; scr[kk * 33 + (lane & 31)] = w; }
    LDS_WAIT(); asm volatile("" ::: "memory");
    const int c = lane & 7;
#pragma unroll
    for (int j = 0; j < 4; ++j) { const int n = (lane >> 3) + 8 * j; const LAS float* s = scr + (8 * c) * 33 + n;
        v4u o; o.x = pk2(s[0 * 33], s[1 * 33]); o.y = pk2(s[2 * 33], s[3 * 33]); o.z = pk2(s[4 * 33], s[5 * 33]); o.w = pk2(s[6 * 33], s[7 * 33]);
        *(GAS v4u*)(WT + (size_t)(dst_row0 + n) * K + k0 + 8 * c) = o; }
    LDS_WAIT(); asm volatile("" ::: "memory");
}
__device__ __forceinline__ int in_src_col(int vc) {
    if (vc >= 1280 && vc < 3328) { const int r = vc - 1280; return ((r >> 7) & 1 ? 2304 : 1280) + 128 * (r >> 8) + (r & 127); }
    if (vc >= 5376) { const int r = vc - 5376; return ((r >> 7) & 1 ? 6400 : 5376) + 128 * (r >> 8) + (r & 127); }
    return vc;
}
struct P0Args { const float *x, *g_mix, *w_in, *wba, *wbh, *wout, *g_ffn, *wg, *wu, *wd; bf16 *Win_t, *Wba_t, *Wbh_t, *Wout_t, *Wgu_t, *Wd_t, *XN; };
__device__ __forceinline__ void p0_prologue(Frame& F, const P0Args& a) {
    LAS float* scr = (LAS float*)(F.lds + RING_OFF + F.wave * 16384);
    const int gw = F.vcu * NWAVES + F.wave, NGW = F.G * NWAVES, lane_ = fresh_tid() & 63;
    constexpr int I_IN = (D / 64) * (INW / 32), I_SQ = (D / 64) * (D / 32), I_GU = (D / 64) * (2 * FF / 32), I_D = (FF / 64) * (D / 32);
    constexpr int NITEMS = I_IN + 3 * I_SQ + I_GU + I_D;
    for (int it = gw; it < NITEMS; it += NGW) {
        int r = it;
        if (r < I_IN) { const int nblk = INW / 32, kb = r / nblk, nb = r % nblk; p0_transpose_item(a.w_in, D, INW, a.Win_t, 64 * kb, in_src_col(32 * nb), 32 * nb, nullptr, scr, lane_); continue; } r -= I_IN;
        if (r < I_SQ) { const int nblk = D / 32, kb = r / nblk, nb = r % nblk; p0_transpose_item(a.wba, D, D, a.Wba_t, 64 * kb, 32 * nb, 32 * nb, nullptr, scr, lane_); continue; } r -= I_SQ;
        if (r < I_SQ) { const int nblk = D / 32, kb = r / nblk, nb = r % nblk; p0_transpose_item(a.wbh, D, D, a.Wbh_t, 64 * kb, 32 * nb, 32 * nb, nullptr, scr, lane_); continue; } r -= I_SQ;
        if (r < I_SQ) { const int nblk = D / 32, kb = r / nblk, nb = r % nblk; p0_transpose_item(a.wout, D, D, a.Wout_t, 64 * kb, 32 * nb, 32 * nb, nullptr, scr, lane_); continue; } r -= I_SQ;
        if (r < I_GU) { const int nblk = 2 * FF / 32, kb = r / nblk, nb = r % nblk, vc = 32 * nb, t = vc >> 8, j = (vc >> 7) & 1, i = vc & 127;
            if (j) p0_transpose_item(a.wu, D, FF, a.Wgu_t, 64 * kb, 128 * t + i, vc, a.g_ffn, scr, lane_); else p0_transpose_item(a.wg, D, FF, a.Wgu_t, 64 * kb, 128 * t + i, vc, a.g_ffn, scr, lane_);
            continue; } r -= I_GU;
        { const int nblk = D / 32, kb = r / nblk, nb = r % nblk; p0_transpose_item(a.wd, FF, D, a.Wd_t, 64 * kb, 32 * nb, 32 * nb, nullptr, scr, lane_); }
    }
    for (int m = gw; m < M; m += NGW) {
        const GAS f32x4* xr = (const GAS f32x4*)(a.x + (size_t)m * D) + lane_; const GAS f32x4* gr = (const GAS f32x4*)a.g_mix + lane_;
        f32x4 v[4]; float s = 0.f;
#pragma unroll
        for (int j = 0; j < 4; ++j) { v[j] = xr[64 * j]; s += (v[j].x * v[j].x + v[j].y * v[j].y) + (v[j].z * v[j].z + v[j].w * v[j].w); }
        const float rstd = 1.f / sqrtf(wave_sum(s) * (1.f / D) + EPS);
        GAS unsigned long long* o8 = (GAS unsigned long long*)(a.XN + (size_t)m * D) + lane_;
#pragma unroll
        for (int j = 0; j < 4; ++j) { const f32x4 g = gr[64 * j]; o8[64 * j] = (unsigned long long)pk2(v[j].x * rstd * g.x, v[j].y * rstd * g.y) | ((unsigned long long)pk2(v[j].z * rstd * g.z, v[j].w * rstd * g.w) << 32); }
    }
}
__device__ __forceinline__ float bf2f(bf16 v) { return __builtin_bit_cast(float, (unsigned)v << 16); }

__device__ __forceinline__ void attn_naive(Frame& F, bf16* AQ, const bf16* AK, const bf16* AV, const float* sinks) {
    const int gw = F.vcu * NWAVES + F.wave, NGW = F.G * NWAVES, d = fresh_tid() & 63;
    for (int w = gw; w < M * 16; w += NGW) {
        const int hq = w & 15, tok = w >> 4, hkv = hq >> 3, b = tok >> 12, i = tok & 4095;
        const float q = bf2f(AQ[(size_t)tok * D + hq * 64 + d]);
        const int j0 = i - 127 < 0 ? 0 : i - 127;
        float m = sinks[hq] * pg8::LOG2E, l = 1.f, o = 0.f;
        for (int j = j0; j <= i; ++j) { const size_t kr = (size_t)(b * SEQ + j) * 128 + hkv * 64 + d;
            float s = wave_sum(q * bf2f(AK[kr]));
            const float mn = fmaxf(m, s), al = pg8::ex2(m - mn), e = pg8::ex2(s - mn);
            l = l * al + e; o = o * al + e * bf2f(AV[kr]); m = mn; }
        AQ[(size_t)tok * D + hq * 64 + d] = (bf16)pk2(o / l, 0.f);
    }
}

namespace att {
typedef float f32x16 __attribute__((ext_vector_type(16)));
typedef short s16x4 __attribute__((ext_vector_type(4)));
typedef short v4i16_t __attribute__((ext_vector_type(4)));
__device__ __forceinline__ s16x4 vtr(LAS const unsigned char* p) { return __builtin_bit_cast(s16x4, __builtin_amdgcn_ds_read_tr16_b64_v4i16((LAS v4i16_t*)p)); }
__device__ __forceinline__ bf16x8 pack8(const f32x16& v, int s) {
    v4u w; w.x = pg8::cvt_pk_bf16(v[8 * s + 0], v[8 * s + 1]); w.y = pg8::cvt_pk_bf16(v[8 * s + 2], v[8 * s + 3]); w.z = pg8::cvt_pk_bf16(v[8 * s + 4], v[8 * s + 5]); w.w = pg8::cvt_pk_bf16(v[8 * s + 6], v[8 * s + 7]);
    return __builtin_bit_cast(bf16x8, w);
}
__device__ __forceinline__ void attn_unit(LAS unsigned char* lds, int unit, bf16* AQ, const bf16* AK, const bf16* AV, const float* sinks) {
    const int tid = fresh_tid(), lane = tid & 63, r = lane & 31, h = lane >> 5, wid = __builtin_amdgcn_readfirstlane(tid >> 6);
    const int b = unit >> 6, hkv = (unit >> 5) & 1, qb = unit & 31;
    const long krow0 = (long)b * SEQ + 128 * (qb - 1);
    LAS unsigned char* Kl = lds; LAS unsigned char* Vl = lds + 32768;
#pragma unroll
    for (int i = 0; i < 4; ++i) { const int p = tid + 512 * i, key = p & 255, c = p >> 8; const bool ok = (qb > 0) || key >= 128;
        v4u kv = (v4u){0u, 0u, 0u, 0u}, vv = (v4u){0u, 0u, 0u, 0u};
        if (ok) { const size_t go = (size_t)(krow0 + key) * 128 + hkv * 64 + c * 8; kv = *(const v4u*)(AK + go); vv = *(const v4u*)(AV + go); }
        *(LAS v4u*)(Kl + c * 4096 + key * 16) = kv;
        *(LAS v4u*)(Vl + (c >> 2) * 16384 + (key >> 4) * 1024 + (key & 15) * 64 + (c & 3) * 16) = vv; }
    __syncthreads();
    const int hq = hkv * 8 + wid; const float sink2 = sinks[hq] * pg8::LOG2E;
    const int vbase = (4 * h + ((lane & 15) >> 2)) * 64 + ((lane >> 4) & 1) * 32 + (lane & 3) * 8;
    for (int qs = 0; qs < 4; ++qs) {
        const size_t tok = (size_t)b * SEQ + 128 * qb + 32 * qs + r;
        bf16* qp = AQ + tok * D + hq * 64;
        bf16x8 qf[4];
#pragma unroll
        for (int ks = 0; ks < 4; ++ks) qf[ks] = *(const bf16x8*)(qp + 16 * ks + 8 * h);
        f32x16 st[5]; float m = sink2;
#pragma unroll
        for (int t = 0; t < 5; ++t) { const int kt = qs + t; const bool live = (qb > 0) || kt >= 4;
            f32x16 a = {};
            if (live) {
#pragma unroll
                for (int ks = 0; ks < 4; ++ks) a = __builtin_amdgcn_mfma_f32_32x32x16_bf16(*(LAS const bf16x8*)(Kl + (2 * ks + h) * 4096 + (32 * kt + r) * 16), qf[ks], a, 0, 0, 0); }
#pragma unroll
            for (int g = 0; g < 16; ++g) { const int kj = (g & 3) + 8 * (g >> 2) + 4 * h; bool keep = live; if (t == 0) keep = keep && (kj > r); if (t == 4) keep = keep && (kj <= r);
                a[g] = keep ? a[g] : -1e30f; m = fmaxf(m, a[g]); }
            st[t] = a; }
        m = fmaxf(m, __shfl_xor(m, 32));
        float l = 0.f;
#pragma unroll
        for (int t = 0; t < 5; ++t)
#pragma unroll
            for (int g = 0; g < 16; ++g) { const float e = pg8::ex2(st[t][g] - m); st[t][g] = e; l += e; }
        l += __shfl_xor(l, 32); l += pg8::ex2(sink2 - m);
        const float rl = 1.f / l;
        f32x16 o0 = {}, o1 = {};
#pragma unroll
        for (int t = 0; t < 5; ++t) { const int kt = qs + t; const bool live = (qb > 0) || kt >= 4;
            if (live) {
#pragma unroll
                for (int s = 0; s < 2; ++s) { const bf16x8 pf = pack8(st[t], s); LAS const unsigned char* vp = Vl + (2 * kt + s) * 1024 + vbase;
                    const s16x4 l0 = vtr(vp), h0 = vtr(vp + 512), l1 = vtr(vp + 16384), h1 = vtr(vp + 16384 + 512);
                    o0 = __builtin_amdgcn_mfma_f32_32x32x16_bf16((bf16x8){l0[0], l0[1], l0[2], l0[3], h0[0], h0[1], h0[2], h0[3]}, pf, o0, 0, 0, 0);
                    o1 = __builtin_amdgcn_mfma_f32_32x32x16_bf16((bf16x8){l1[0], l1[1], l1[2], l1[3], h1[0], h1[1], h1[2], h1[3]}, pf, o1, 0, 0, 0); } } }
#pragma unroll
        for (int g = 0; g < 4; ++g) { typedef unsigned u32x2 __attribute__((ext_vector_type(2)));
            u32x2 w0, w1; w0.x = pg8::cvt_pk_bf16(o0[4 * g] * rl, o0[4 * g + 1] * rl); w0.y = pg8::cvt_pk_bf16(o0[4 * g + 2] * rl, o0[4 * g + 3] * rl);
            w1.x = pg8::cvt_pk_bf16(o1[4 * g] * rl, o1[4 * g + 1] * rl); w1.y = pg8::cvt_pk_bf16(o1[4 * g + 2] * rl, o1[4 * g + 3] * rl);
            *(u32x2*)(qp + 8 * g + 4 * h) = w0; *(u32x2*)(qp + 32 + 8 * g + 4 * h) = w1; }
    }
    __syncthreads();
}
}

namespace hg {
using att::f32x16; using att::s16x4; using att::vtr; using att::pack8;
constexpr int SMALL_OFF = 132096;
constexpr int O_Q1R = 0, O_K1R = 16384, O_K1T = 32768, O_VT = 49152, BUFB = 65536;
struct Tn { const bf16 *Q1, *K1, *V; bf16* SG; const float *BMID, *BLAST, *ng; float *L, *DS; };
#define HG_GLDS(src, dstoff) __builtin_amdgcn_global_load_lds((const unsigned*)(src), (LAS unsigned*)(lds + (dstoff)), 16, 0, 0)
template <bool OUT>
__device__ __forceinline__ void stage(LAS unsigned char* lds, const Tn& t, size_t row0, int col0, int buf, int wid, int lane) {
    if (OUT) { const int ty = wid >> 1;
#pragma unroll
        for (int i = 0; i < 8; ++i) { const int sub = (wid & 1) * 8 + i;
            if (ty < 2) { const bf16* T = ty == 0 ? t.Q1 : t.K1; HG_GLDS(T + (row0 + lane) * D + col0 + sub * 8, buf * BUFB + (ty == 0 ? O_Q1R : O_K1R) + sub * 1024); }
            else { const bf16* T = ty == 2 ? t.K1 : t.V; const int cg = sub >> 2, rg = sub & 3; HG_GLDS(T + (row0 + rg * 16 + (lane >> 2)) * D + col0 + cg * 32 + (lane & 3) * 8, buf * BUFB + (ty == 2 ? O_K1T : O_VT) + sub * 1024); } }
    } else { const int ty = 2 + (wid >> 2);
#pragma unroll
        for (int i = 0; i < 4; ++i) { const int sub = (wid & 3) * 4 + i, cg = sub >> 2, rg = sub & 3; const bf16* T = ty == 2 ? t.K1 : t.V;
            HG_GLDS(T + (row0 + rg * 16 + (lane >> 2)) * D + col0 + cg * 32 + (lane & 3) * 8, buf * BUFB + (ty == 2 ? O_K1T : O_VT) + sub * 1024); }
    }
}
template <bool OUT>
__device__ __forceinline__ void hgrn_unit(LAS unsigned char* lds, int unit, const Tn& t) {
    const int tid = fresh_tid(), lane = tid & 63, r = lane & 31, hl = lane >> 5, wid = __builtin_amdgcn_readfirstlane(tid >> 6), vt = wid & 3, ct = wid >> 2;
    const int b = unit >> 6, h = (unit >> 3) & 7, seg = unit & 7, col0 = h * 128, c0 = seg * 8;
    LAS float* gfac = (LAS float*)(lds + SMALL_OFF); LAS float* ssq = gfac + 256;
    const int vbase = (4 * hl + ((lane & 15) >> 2)) * 64 + ((lane >> 4) & 1) * 32 + (lane & 3) * 8;
    f32x16 S[4];
#pragma unroll
    for (int kt = 0; kt < 4; ++kt) S[kt] = (f32x16){};
    if (OUT) {
        for (int j = 0; j < seg; ++j) { const int uj = unit - seg + j;
#pragma unroll
            for (int kt = 0; kt < 4; ++kt)
#pragma unroll
                for (int g = 0; g < 4; ++g) { const f32x4 d = *(const f32x4*)(t.DS + (size_t)uj * 128 + 32 * kt + 8 * g + 4 * hl); const f32x4 lv = *(const f32x4*)(t.L + ((((size_t)uj * 4 + kt) * 4 + vt) * 4 + g) * 256 + lane * 4);
#pragma unroll
                    for (int i = 0; i < 4; ++i) S[kt][4 * g + i] = d[i] * S[kt][4 * g + i] + lv[i]; } }
    }
    { const size_t row0 = (size_t)b * SEQ + (size_t)c0 * 64; stage<OUT>(lds, t, row0, col0, 0, wid, lane);
      if (tid < 128) gfac[tid] = pg8::ex2(t.BMID[(size_t)(b * 64 + c0) * 1024 + col0 + tid]); }
    asm volatile("s_waitcnt vmcnt(0)" ::: "memory"); __syncthreads();
    for (int i = 0; i < 8; ++i) {
        const int c = c0 + i, cur = i & 1, cr = b * 64 + c; const size_t row0 = (size_t)b * SEQ + (size_t)c * 64;
        LAS const unsigned char* B = lds + cur * BUFB;
        if (i + 1 < 8) stage<OUT>(lds, t, row0 + 64, col0, cur ^ 1, wid, lane);
        float bmn = 0.f, bmc = 0.f, blc = 0.f;
        if (tid < 128) { bmc = t.BMID[(size_t)cr * 1024 + col0 + tid]; blc = t.BLAST[(size_t)cr * 1024 + col0 + tid]; if (i + 1 < 8) bmn = t.BMID[(size_t)(cr + 1) * 1024 + col0 + tid]; }
        typedef unsigned u32x2 __attribute__((ext_vector_type(2)));
        bf16* yp = t.SG + (row0 + 32 * ct + r) * D + col0 + 32 * vt + 4 * hl;
        u32x2 gate[4];
        if (OUT) {
#pragma unroll
            for (int g = 0; g < 4; ++g) gate[g] = *(const u32x2*)(yp + 8 * g); }
#pragma unroll
        for (int kt = 0; kt < 4; ++kt)
#pragma unroll
            for (int g = 0; g < 4; ++g) { const f32x4 gf = *(LAS const f32x4*)(gfac + cur * 128 + 32 * kt + 8 * g + 4 * hl);
#pragma unroll
                for (int e = 0; e < 4; ++e) S[kt][4 * g + e] *= gf[e]; }
        bf16x8 vf[4];
#pragma unroll
        for (int rg = 0; rg < 4; ++rg) { LAS const unsigned char* vp = B + O_VT + (vt * 4 + rg) * 1024 + vbase; const s16x4 lo = vtr(vp), hi = vtr(vp + 512); vf[rg] = (bf16x8){lo[0], lo[1], lo[2], lo[3], hi[0], hi[1], hi[2], hi[3]}; }
        f32x16 o = {};
        if (OUT) {
#pragma unroll
            for (int st = 0; st < 2; ++st) {
                if (st <= ct) { f32x16 x = {};
#pragma unroll
                    for (int ks = 0; ks < 8; ++ks) x = __builtin_amdgcn_mfma_f32_32x32x16_bf16(*(LAS const bf16x8*)(B + O_K1R + (2 * ks + hl) * 1024 + (32 * st + r) * 16), *(LAS const bf16x8*)(B + O_Q1R + (2 * ks + hl) * 1024 + (32 * ct + r) * 16), x, 0, 0, 0);
                    if (st == ct) {
#pragma unroll
                        for (int g = 0; g < 16; ++g) { const int sj = (g & 3) + 8 * (g >> 2) + 4 * hl; x[g] = sj <= r ? x[g] : 0.f; } }
#pragma unroll
                    for (int s2 = 0; s2 < 2; ++s2) o = __builtin_amdgcn_mfma_f32_32x32x16_bf16(vf[2 * st + s2], pack8(x, s2), o, 0, 0, 0); } }
#pragma unroll
            for (int kt = 0; kt < 4; ++kt)
#pragma unroll
                for (int s = 0; s < 2; ++s) { LAS const unsigned char* qp = B + O_Q1R + (4 * kt + 2 * s) * 1024 + (32 * ct + r) * 16 + 8 * hl;
                    const u32x2 q0 = *(LAS const u32x2*)qp, q1 = *(LAS const u32x2*)(qp + 1024); const v4u qq = (v4u){q0.x, q0.y, q1.x, q1.y};
                    o = __builtin_amdgcn_mfma_f32_32x32x16_bf16(pack8(S[kt], s), __builtin_bit_cast(bf16x8, qq), o, 0, 0, 0); }
        }
#pragma unroll
        for (int kt = 0; kt < 4; ++kt)
#pragma unroll
            for (int ss = 0; ss < 4; ++ss) { LAS const unsigned char* kp = B + O_K1T + (kt * 4 + ss) * 1024 + vbase; const s16x4 lo = vtr(kp), hi = vtr(kp + 512);
                S[kt] = __builtin_amdgcn_mfma_f32_32x32x16_bf16((bf16x8){lo[0], lo[1], lo[2], lo[3], hi[0], hi[1], hi[2], hi[3]}, vf[ss], S[kt], 0, 0, 0); }
        if (OUT) {
            float q = 0.f;
#pragma unroll
            for (int g = 0; g < 16; ++g) q += o[g] * o[g];
            q += __shfl_xor(q, 32);
            if (hl == 0) ssq[(ct * 4 + vt) * 32 + r] = q;
            __syncthreads();
            const float tot = (ssq[(ct * 4 + 0) * 32 + r] + ssq[(ct * 4 + 1) * 32 + r]) + (ssq[(ct * 4 + 2) * 32 + r] + ssq[(ct * 4 + 3) * 32 + r]);
            const float rs = __builtin_amdgcn_rsqf(tot * (1.f / 128.f) + EPS);
#pragma unroll
            for (int g = 0; g < 4; ++g) { const f32x4 gn = *(const f32x4*)(t.ng + col0 + 32 * vt + 8 * g + 4 * hl);
                const float y0 = o[4 * g] * rs * gn[0] * pg8::bf_lo(gate[g].x), y1 = o[4 * g + 1] * rs * gn[1] * pg8::bf_hi(gate[g].x), y2 = o[4 * g + 2] * rs * gn[2] * pg8::bf_lo(gate[g].y), y3 = o[4 * g + 3] * rs * gn[3] * pg8::bf_hi(gate[g].y);
                u32x2 w; w.x = pg8::cvt_pk_bf16(y0, y1); w.y = pg8::cvt_pk_bf16(y2, y3); *(u32x2*)(yp + 8 * g) = w; }
        }
        if (tid < 128) gfac[(cur ^ 1) * 128 + tid] = pg8::ex2(bmn + blc - bmc);
        asm volatile("s_waitcnt vmcnt(0)" ::: "memory"); __syncthreads();
    }
    if (!OUT) {
#pragma unroll
        for (int kt = 0; kt < 4; ++kt)
#pragma unroll
            for (int g = 0; g < 4; ++g) { const f32x4 gf = *(LAS const f32x4*)(gfac + 32 * kt + 8 * g + 4 * hl); f32x4 lv;
#pragma unroll
                for (int e = 0; e < 4; ++e) lv[e] = S[kt][4 * g + e] * gf[e];
                if (ct == 0) *(f32x4*)(t.L + ((((size_t)unit * 4 + kt) * 4 + vt) * 4 + g) * 256 + lane * 4) = lv; }
        if (tid < 128) { float sb = 0.f; for (int i = 0; i < 8; ++i) sb += t.BLAST[(size_t)(b * 64 + c0 + i) * 1024 + col0 + tid]; t.DS[(size_t)unit * 128 + tid] = pg8::ex2(sb); }
    }
    __syncthreads();
}
}
__device__ __forceinline__ void hgrn_naive(Frame& F, int unit, const bf16* Q1, const bf16* K1, const bf16* V, bf16* SG, const float* BMID, const float* BLAST, const float* ng) {
    const int b = unit >> 3, h = unit & 7, tid = fresh_tid();
    LAS float* Sst = (LAS float*)(F.lds);
    LAS bf16* Qs = (LAS bf16*)(F.lds + 65536);
    LAS bf16* Ks = (LAS bf16*)(F.lds + 81920);
    LAS bf16* Vs = (LAS bf16*)(F.lds + 98304);
    LAS float* As = (LAS float*)(F.lds + 114688);
    for (int i = tid; i < 128 * 128; i += 512) Sst[i] = 0.f;
    __syncthreads();
    for (int c = 0; c < 64; ++c) {
        const size_t row0 = (size_t)b * SEQ + c * 64; const int cr = b * 64 + c;
        for (int i = tid; i < 64 * 16; i += 512) { const int r = i >> 4, ch = i & 15; const size_t go = (row0 + r) * D + h * 128 + ch * 8;
            *(LAS v4u*)(Qs + r * 128 + ch * 8) = *(const v4u*)(Q1 + go); *(LAS v4u*)(Ks + r * 128 + ch * 8) = *(const v4u*)(K1 + go); *(LAS v4u*)(Vs + r * 128 + ch * 8) = *(const v4u*)(V + go); }
        __syncthreads();
        { const int cc = tid >> 3, sg = tid & 7;
#pragma unroll
            for (int u = 0; u < 8; ++u) { const int s = sg * 8 + u; float a = 0.f;
                if (s <= cc) for (int k = 0; k < 128; ++k) a += bf2f(Qs[cc * 128 + k]) * bf2f(Ks[s * 128 + k]);
                As[cc * 64 + s] = a; } }
        __syncthreads();
        { const int cc = tid >> 3, v0 = (tid & 7) * 16; float o[16];
#pragma unroll
            for (int j = 0; j < 16; ++j) o[j] = 0.f;
            for (int s = 0; s <= cc; ++s) { const float a = As[cc * 64 + s];
#pragma unroll
                for (int j = 0; j < 16; ++j) o[j] += a * bf2f(Vs[s * 128 + v0 + j]); }
            for (int k = 0; k < 128; ++k) { const float qk = bf2f(Qs[cc * 128 + k]) * pg8::ex2(BMID[(size_t)cr * 1024 + h * 128 + k]);
#pragma unroll
                for (int j = 0; j < 16; ++j) o[j] += qk * Sst[k * 128 + v0 + j]; }
            float ss = 0.f;
#pragma unroll
            for (int j = 0; j < 16; ++j) ss += o[j] * o[j];
            ss += __shfl_xor(ss, 1); ss += __shfl_xor(ss, 2); ss += __shfl_xor(ss, 4);
            const float r = 1.f / sqrtf(ss * (1.f / 128.f) + EPS);
            bf16* gp = SG + (row0 + cc) * D + h * 128 + v0;
#pragma unroll
            for (int j = 0; j < 16; ++j) gp[j] = (bf16)pk2(o[j] * r * ng[h * 128 + v0 + j] * bf2f(gp[j]), 0.f); }
        __syncthreads();
        { const int k = tid >> 2, v0 = (tid & 3) * 32; float acc[32];
#pragma unroll
            for (int j = 0; j < 32; ++j) acc[j] = 0.f;
            for (int s = 0; s < 64; ++s) { const float kv = bf2f(Ks[s * 128 + k]);
#pragma unroll
                for (int j = 0; j < 32; ++j) acc[j] += kv * bf2f(Vs[s * 128 + v0 + j]); }
            const float bmv = BMID[(size_t)cr * 1024 + h * 128 + k], blv = BLAST[(size_t)cr * 1024 + h * 128 + k]; const float e1 = pg8::ex2(blv), e2 = pg8::ex2(blv - bmv);
#pragma unroll
            for (int j = 0; j < 32; ++j) Sst[k * 128 + v0 + j] = e1 * Sst[k * 128 + v0 + j] + e2 * acc[j]; }
        __syncthreads();
    }
}
__device__ __forceinline__ void final_norm(Frame& F, float* out, const float* SSQ2, const float* g_fin) {
    const int gw = F.vcu * NWAVES + F.wave, NGW = F.G * NWAVES, lane_ = fresh_tid() & 63;
    for (int m = gw; m < M; m += NGW) {
        const float p = lane_ < 16 ? SSQ2[(size_t)m * 16 + lane_] : 0.f; const float r = 1.f / sqrtf(wave_sum(p) * (1.f / D) + EPS);
        GAS f32x4* xr = (GAS f32x4*)(out + (size_t)m * D) + lane_; const GAS f32x4* gr = (const GAS f32x4*)g_fin + lane_;
#pragma unroll
        for (int j = 0; j < 4; ++j) { const f32x4 v = xr[64 * j], g = gr[64 * j]; xr[64 * j] = v * r * g; }
    }
}

struct Args { const float* in[15]; float* out; unsigned char* ws; int ph_lo, ph_hi; };
static_assert(sizeof(Args) == 15 * 8 + 8 + 8 + 8, "Args has no padding");
constexpr int N_PHASES = 8;

__global__ void __launch_bounds__(NWAVES * 64, 2) mk_fwd(Args args) {
    extern __shared__ __attribute__((aligned(16))) unsigned char lds[];
    Frame F;
    F.lds = (LAS unsigned char*)lds;
    F.MISC = (volatile LAS unsigned*)(F.lds + MISC_OFF);
    F.tid = threadIdx.x; F.lane = F.tid & 63; F.wave = __builtin_amdgcn_readfirstlane(F.tid >> 6);
    F.G = gridDim.x; { const int bx = blockIdx.x; F.vcu = (F.G % 8 == 0) ? (bx % 8) * (F.G / 8) + bx / 8 : bx; }
    unsigned char* ws = args.ws;
    F.ctl = (gu32*)(ws + WS_CTL);
    for (int u = F.tid; u < (LDS_BYTES - LDSCTL_OFF) / 4; u += NWAVES * 64) ((LAS unsigned*)(F.lds + LDSCTL_OFF))[u] = 0u;
    __syncthreads();
    const int lo = args.ph_lo, hi = args.ph_hi; const bool IN2_ = lo <= 2 && 2 < hi;
    XcdBarrier bar; bar.bar = (unsigned*)(F.ctl + CW_BAR); bar.x = 0; bar.st = nullptr;
    if (hi - lo > 1 || IN2_) bar = xcd_barrier_post((unsigned*)(F.ctl + CW_BAR), F.MISC + 8);
#define IN(k) (lo <= (k) && (k) < hi)
#define SEAM(k) do { if (IN(k) && IN((k) + 1)) xcd_barrier(bar); } while (0)
    const float* x = args.in[0]; const float* b_in = args.in[3]; const float* sinks = args.in[4]; const float* lbl = args.in[5]; const float* ng = args.in[6]; const float* g_fin = args.in[14];
    float* out = args.out;
    bf16* Win_t = (bf16*)(ws + WS_WIN); bf16* Wba_t = (bf16*)(ws + WS_WBA); bf16* Wbh_t = (bf16*)(ws + WS_WBH); bf16* Wout_t = (bf16*)(ws + WS_WOUT); bf16* Wgu_t = (bf16*)(ws + WS_WGU); bf16* Wd_t = (bf16*)(ws + WS_WD);
    bf16* XN = (bf16*)(ws + WS_XN); bf16* AQ = (bf16*)(ws + WS_AQ); bf16* AK = (bf16*)(ws + WS_AK); bf16* AV = (bf16*)(ws + WS_AV); bf16* Q1 = (bf16*)(ws + WS_Q1); bf16* K1 = (bf16*)(ws + WS_K1);
    bf16* V = (bf16*)(ws + WS_V); bf16* SG = (bf16*)(ws + WS_SG); bf16* MG = (bf16*)(ws + WS_MG); bf16* Z = (bf16*)(ws + WS_Z);
    bf16* SR = (bf16*)out; bf16* SB = SR + (size_t)M * D;
    float* BMID = (float*)(ws + WS_BM); float* BLAST = (float*)(ws + WS_BL); float* SSQ = (float*)(ws + WS_SSQ); float* SSQ2 = (float*)(ws + WS_SSQ2);

    if (IN(0)) { P0Args a{x, args.in[1], args.in[2], args.in[7], args.in[8], args.in[9], args.in[10], args.in[11], args.in[12], args.in[13], Win_t, Wba_t, Wbh_t, Wout_t, Wgu_t, Wd_t, XN}; p0_prologue(F, a); }
    SEAM(0);
    if (IN(1)) {
        pg8::Gemm g{XN, Win_t, M, INW, D, D, nullptr, nullptr, 0}; pg8::StaticOrder S; S.init(M, INW, F.G, (int)blockIdx.x);
        pg8::EpiIn E{AQ, AK, AV, Q1, K1, V, SG, SR, SB, BMID, BLAST, b_in, lbl};
        pg8::gemm_phase<pg8::EpiIn, pg8::StaticOrder, true, true, false>(F.lds + RING_OFF, g, S, E);
    }
    SEAM(1);
    if (IN(2)) {
        for (int u = F.vcu; u < 256; u += F.G) att::attn_unit(F.lds + RING_OFF, u, AQ, AK, AV, sinks);
        hg::Tn ht{Q1, K1, V, SG, BMID, BLAST, ng, (float*)(ws + WS_L), (float*)(ws + WS_SSQ2)};
        for (int u = F.vcu; u < 256; u += F.G) hg::hgrn_unit<false>(F.lds, u, ht);
        xcd_barrier(bar);
        for (int u = F.vcu; u < 256; u += F.G) hg::hgrn_unit<true>(F.lds, u, ht);
    }
    SEAM(2);
    if (IN(3)) {
        pg8::Gemm g{AQ, Wba_t, M, D, 2 * D, D, SG, Wbh_t, D / 64}; pg8::StaticOrder S; S.init(M, D, F.G, (int)blockIdx.x);
        pg8::EpiMerge E{SR, SB, MG};
        pg8::gemm_phase<pg8::EpiMerge, pg8::StaticOrder, false, true, true>(F.lds + RING_OFF, g, S, E);
    }
    SEAM(3);
    if (IN(4)) {
        pg8::Gemm g{MG, Wout_t, M, D, D, D, nullptr, nullptr, 0}; pg8::StaticOrder S; S.init(M, D, F.G, (int)blockIdx.x);
        pg8::EpiRes E{x, out, XN, SSQ};
        pg8::gemm_phase<pg8::EpiRes, pg8::StaticOrder, false, true, false>(F.lds + RING_OFF, g, S, E);
    }
    SEAM(4);
    if (IN(5)) {
        pg8::Gemm g{XN, Wgu_t, M, 2 * FF, D, D, nullptr, nullptr, 0}; pg8::StaticOrder S; S.init(M, 2 * FF, F.G, (int)blockIdx.x);
        pg8::EpiGU E{SSQ, Z};
        pg8::gemm_phase<pg8::EpiGU, pg8::StaticOrder, true, true, false>(F.lds + RING_OFF, g, S, E);
    }
    SEAM(5);
    if (IN(6)) {
        pg8::Gemm g{Z, Wd_t, M, D, FF, FF, nullptr, nullptr, 0}; pg8::StaticOrder S; S.init(M, D, F.G, (int)blockIdx.x);
        pg8::EpiRes E{out, out, nullptr, SSQ2};
        pg8::gemm_phase<pg8::EpiRes, pg8::StaticOrder, false, true, false>(F.lds + RING_OFF, g, S, E);
    }
    SEAM(6);
    if (IN(7)) final_norm(F, out, SSQ2, g_fin);
#undef IN
#undef SEAM
}


#if defined(MK_DEBUG)
namespace dbg {
constexpr size_t WS_FLAGS = 244 * MiB, WS_EXP_ATT = 245 * MiB, WS_PSM = 246 * MiB;
constexpr int NS_ATT = 2048, HG_TOK = 1024, NS_FIN = 512;
constexpr size_t WS_EXP_FIN = 248 * MiB;
__device__ __forceinline__ void flag(float* F, int k, float e) { if (!(e >= 0.f)) e = 1e30f; atomicMax((int*)F + k, __float_as_int(e)); }
__device__ __forceinline__ float nerr(float got, float exp, float rel, float abst) { return fabsf(got - exp) / (rel * fabsf(exp) + abst); }
__device__ __forceinline__ float bsum(float v, float* red) {
    const int t = threadIdx.x; red[t] = v; __syncthreads();
    for (int o = 128; o > 0; o >>= 1) { if (t < o) red[t] += red[t + o]; __syncthreads(); }
    const float r = red[0]; __syncthreads(); return r;
}
__device__ __forceinline__ void load_u(const float* x, const float* g, int row, float* us, float* red) {
    const int t = threadIdx.x; float s = 0.f;
    for (int k = t; k < D; k += 256) { const float v = x[(size_t)row * D + k]; s += v * v; }
    const float r = rsqrtf(bsum(s, red) / D + EPS);
    for (int k = t; k < D; k += 256) us[k] = x[(size_t)row * D + k] * r * g[k];
    __syncthreads();
}
__device__ __forceinline__ float pdot(const float* us, const float* w_in, const float* b_in, int oc, float* red) {
    float s = 0.f; for (int k = threadIdx.x; k < D; k += 256) s += us[k] * w_in[(size_t)k * INW + oc];
    return bsum(s, red) + b_in[oc];
}
__device__ __forceinline__ unsigned mix(unsigned s) { unsigned h = s * 0x9E3779B1u; h ^= h >> 16; h *= 0x85EBCA6Bu; h ^= h >> 13; h *= 0xC2B2AE35u; h ^= h >> 16; return h; }
__device__ __forceinline__ float sg_(float v) { return 1.f / (1.f + __expf(-v)); }
__global__ void chk_p1(const float* x, const float* g, const float* w_in, const float* b_in, const bf16* AQ, const bf16* AK, const bf16* AV, const bf16* V, const bf16* SG, const bf16* SR, const bf16* SB, float* F) {
    __shared__ float us[1024], red[256];
    const unsigned hh_ = mix(blockIdx.x); const int row = (int)(hh_ % (unsigned)M), c = (int)((hh_ >> 14) % 1024u);
    load_u(x, g, row, us, red);
    const float aq = pdot(us, w_in, b_in, c, red), ak = pdot(us, w_in, b_in, 1024 + (c & 127), red), av = pdot(us, w_in, b_in, 1152 + (c & 127), red), hi = pdot(us, w_in, b_in, 3328 + c, red),
                hg = pdot(us, w_in, b_in, 4352 + c, red), ga = pdot(us, w_in, b_in, 5376 + c, red), gb = pdot(us, w_in, b_in, 6400 + c, red);
    if (threadIdx.x == 0) {
        float e = nerr(bf2f(AQ[(size_t)row * D + c]), aq * pg8::C2, 0.02f, 0.004f);
        e = fmaxf(e, nerr(bf2f(AK[(size_t)row * 128 + (c & 127)]), ak, 0.02f, 0.02f)); e = fmaxf(e, nerr(bf2f(AV[(size_t)row * 128 + (c & 127)]), av, 0.02f, 0.02f));
        e = fmaxf(e, nerr(bf2f(V[(size_t)row * D + c]), hi, 0.02f, 0.02f)); e = fmaxf(e, nerr(bf2f(SG[(size_t)row * D + c]), sg_(hg), 0.02f, 0.01f));
        e = fmaxf(e, nerr(bf2f(SB[(size_t)row * D + c]), sg_(gb), 0.02f, 0.01f)); e = fmaxf(e, nerr(bf2f(SR[(size_t)row * D + c]), sg_(ga) / sg_(gb), 0.03f, 0.02f));
        flag(F, 0, e); }
}
__global__ void chk_p1h(const float* x, const float* g, const float* w_in, const float* b_in, const float* lbl, const bf16* Q1, const bf16* K1, const float* BMID, const float* BLAST, float* F) {
    __shared__ float us[1024], red[256], hq[64], hf[64];
    const unsigned hh_ = mix(blockIdx.x + 77u); const int cr = (int)(hh_ % 256u), ch = (int)((hh_ >> 8) % 1024u);
    for (int r = 0; r < 64; ++r) { load_u(x, g, cr * 64 + r, us, red); const float a = pdot(us, w_in, b_in, 1280 + ch, red), b = pdot(us, w_in, b_in, 2304 + ch, red); if (threadIdx.x == 0) { hq[r] = a; hf[r] = b; } }
    __syncthreads();
    if (threadIdx.x == 0) {
        const float l0 = lbl[ch], l1 = lbl[1024 + ch], lb = 1.f / (1.f + __expf(l1 - l0));
        float cum = 0.f, e = 0.f;
        for (int r = 0; r < 64; ++r) { const float s = sg_(hf[r]), f = lb + (1.f - lb) * s; cum += log2f(f); hf[r] = cum; hq[r] = hq[r] * sg_(hq[r]); red[r] = (1.f - lb) * (1.f - s); }
        const float bm = hf[31], bl = hf[63];
        e = fmaxf(e, nerr(BMID[(size_t)cr * 1024 + ch], bm, 0.01f, 0.02f)); e = fmaxf(e, nerr(BLAST[(size_t)cr * 1024 + ch], bl, 0.01f, 0.02f));
        for (int r = 0; r < 64; ++r) { const float q1 = hq[r] * exp2f(hf[r] - bm), k1 = red[r] * exp2f(bm - hf[r]);
            e = fmaxf(e, nerr(bf2f(Q1[(size_t)(cr * 64 + r) * D + ch]), q1, 0.04f, 2e-2f * exp2f(hf[r] - bm))); e = fmaxf(e, nerr(bf2f(K1[(size_t)(cr * 64 + r) * D + ch]), k1, 0.04f, 2e-2f * exp2f(bm - hf[r]))); }
        flag(F, 1, e); }
}
__global__ void exp_attn(const bf16* AQ, const bf16* AK, const bf16* AV, const float* sinks, float* EX) {
    const int s = blockIdx.x * 4 + (threadIdx.x >> 6), d = threadIdx.x & 63; if (s >= NS_ATT) return;
    const unsigned hh_ = mix(s + 999u); const int tok = (int)(hh_ % (unsigned)M), hq = (int)((hh_ >> 14) % 16u), hkv = hq >> 3, b = tok >> 12, i = tok & 4095, j0 = i - 127 < 0 ? 0 : i - 127;
    const float q = bf2f(AQ[(size_t)tok * D + hq * 64 + d]);
    float m = sinks[hq] * pg8::LOG2E;
    for (int j = j0; j <= i; ++j) m = fmaxf(m, wave_sum(q * bf2f(AK[(size_t)(b * SEQ + j) * 128 + hkv * 64 + d])));
    float l = exp2f(sinks[hq] * pg8::LOG2E - m), o = 0.f;
    for (int j = j0; j <= i; ++j) { const float e = exp2f(wave_sum(q * bf2f(AK[(size_t)(b * SEQ + j) * 128 + hkv * 64 + d])) - m); l += e; o += e * bf2f(AV[(size_t)(b * SEQ + j) * 128 + hkv * 64 + d]); }
    EX[(size_t)s * 64 + d] = o / l;
}
__global__ void chk_attn(const bf16* YA, const float* EX, float* F) {
    const int s = blockIdx.x * 4 + (threadIdx.x >> 6), d = threadIdx.x & 63; if (s >= NS_ATT) return;
    const unsigned hh_ = mix(s + 999u); const int tok = (int)(hh_ % (unsigned)M), hq = (int)((hh_ >> 14) % 16u);
    flag(F, 2, nerr(bf2f(YA[(size_t)tok * D + hq * 64 + d]), EX[(size_t)s * 64 + d], 0.03f, 0.02f));
}
__global__ void exp_hgrn_p(const float* x, const float* g, const float* w_in, const float* b_in, int bb, int hh, float* PS) {
    __shared__ float us[1024], red[256];
    const int tok = blockIdx.x; load_u(x, g, bb * SEQ + tok, us, red);
    for (int c = 0; c < 512; ++c) { const int oc = (c < 128 ? 1280 : c < 256 ? 2304 : c < 384 ? 3328 : 4352) + hh * 128 + (c & 127); const float v = pdot(us, w_in, b_in, oc, red); if (threadIdx.x == 0) PS[(size_t)tok * 512 + c] = v; }
}
__global__ void chk_hgrn(const float* PS, const float* lbl, const float* ng, const bf16* YH, int bb, int hh, float* F) {
    __shared__ float fq[128], fk[128], ff[128], red[128], po[4][128];
    const int v = threadIdx.x & 127, kq = threadIdx.x >> 7; float S[32];
#pragma unroll
    for (int k = 0; k < 32; ++k) S[k] = 0.f;
    const float l0 = lbl[hh * 128 + v], l1 = lbl[1024 + hh * 128 + v], lb = 1.f / (1.f + __expf(l1 - l0));
    float emax = 0.f;
    for (int t = 0; t < HG_TOK; ++t) {
        const float* p = PS + (size_t)t * 512;
        if (kq == 0) { const float hq = p[v], hf = p[128 + v], s = sg_(hf); fq[v] = hq * sg_(hq); ff[v] = lb + (1.f - lb) * s; fk[v] = (1.f - lb) * (1.f - s); }
        __syncthreads();
        const float vv = p[256 + v]; float o = 0.f;
#pragma unroll
        for (int k = 0; k < 32; ++k) { S[k] = ff[kq * 32 + k] * S[k] + fk[kq * 32 + k] * vv; o += fq[kq * 32 + k] * S[k]; }
        po[kq][v] = o; __syncthreads();
        o = po[0][v] + po[1][v] + po[2][v] + po[3][v];
        if (kq == 0) red[v] = o * o;
        __syncthreads();
        for (int w = 64; w > 0; w >>= 1) { if (kq == 0 && v < w) red[v] += red[v + w]; __syncthreads(); }
        const float r = rsqrtf(red[0] / 128.f + EPS), y = o * r * ng[hh * 128 + v] * sg_(p[384 + v]);
        if (kq == 0) emax = fmaxf(emax, nerr(bf2f(YH[(size_t)(bb * SEQ + t) * D + hh * 128 + v]), y, 0.05f, 0.03f));
        __syncthreads();
    }
    if (kq == 0) flag(F, 3, emax);
}
__global__ void chk_mg(const bf16* YA, const bf16* YH, const bf16* SR, const bf16* SB, const float* wba, const float* wbh, const bf16* MG, float* F) {
    const int s = blockIdx.x * blockDim.x + threadIdx.x; const unsigned hh_ = mix(s + 31337u); const int row = (int)(hh_ % (unsigned)M), c = (int)((hh_ >> 14) % 1024u);
    float a = 0.f, b = 0.f; for (int k = 0; k < D; ++k) { a += bf2f(YA[(size_t)row * D + k]) * wba[(size_t)k * D + c]; b += bf2f(YH[(size_t)row * D + k]) * wbh[(size_t)k * D + c]; }
    const float sb = bf2f(SB[(size_t)row * D + c]), sr = bf2f(SR[(size_t)row * D + c]);
    flag(F, 4, nerr(bf2f(MG[(size_t)row * D + c]), sr * sb * a + sb * b, 0.03f, 0.02f));
}
__global__ void chk_h1(const float* x, const bf16* MG, const float* wout, const float* H1, const float* SSQ, float* F) {
    const int s = blockIdx.x * blockDim.x + threadIdx.x; const unsigned hh_ = mix(s + 31337u); const int row = (int)(hh_ % (unsigned)M), c = (int)((hh_ >> 14) % 1024u);
    float a = 0.f; for (int k = 0; k < D; ++k) a += bf2f(MG[(size_t)row * D + k]) * wout[(size_t)k * D + c];
    float e = nerr(H1[(size_t)row * D + c], x[(size_t)row * D + c] + a, 0.01f, 0.02f);
    float q = 0.f, p = 0.f; for (int k = 0; k < D; ++k) { const float v = H1[(size_t)row * D + k]; q += v * v; } for (int k = 0; k < 16; ++k) p += SSQ[(size_t)row * 16 + k];
    e = fmaxf(e, nerr(p, q, 0.001f, 0.f)); flag(F, 5, e);
}
__global__ void chk_z(const float* H1, const float* gffn, const float* wg, const float* wu, const bf16* Z, float* F) {
    __shared__ float red[256];
    const unsigned hh_ = mix(blockIdx.x + 4242u); const int row = (int)(hh_ % (unsigned)M), f = (int)((hh_ >> 14) % (unsigned)FF);
    float s = 0.f; for (int k = threadIdx.x; k < D; k += 256) { const float v = H1[(size_t)row * D + k]; s += v * v; }
    const float r = rsqrtf(bsum(s, red) / D + EPS);
    float a = 0.f, b = 0.f; for (int k = threadIdx.x; k < D; k += 256) { const float u = H1[(size_t)row * D + k] * r * gffn[k]; a += u * wg[(size_t)k * FF + f]; b += u * wu[(size_t)k * FF + f]; }
    a = bsum(a, red); b = bsum(b, red);
    if (threadIdx.x == 0) flag(F, 6, nerr(bf2f(Z[(size_t)row * FF + f]), a * sg_(a) * b, 0.04f, 0.02f));
}
__global__ void chk_h2(const bf16* H1b, const bf16* Z, const float* wd, const float* H2, float* F) {
    const int s = blockIdx.x * blockDim.x + threadIdx.x; const unsigned hh_ = mix(s + 31337u); const int row = (int)(hh_ % (unsigned)M), c = (int)((hh_ >> 14) % 1024u);
    float a = 0.f; for (int k = 0; k < FF; ++k) a += bf2f(Z[(size_t)row * FF + k]) * wd[(size_t)k * D + c];
    flag(F, 7, nerr(H2[(size_t)row * D + c], bf2f(H1b[(size_t)row * D + c]) + a, 0.02f, 0.03f));
}
__global__ void exp_final(const float* H2, const float* gfin, float* EXF) {
    __shared__ float red[256];
    const int row = (int)((blockIdx.x * 2654435761u) % (unsigned)M);
    float s = 0.f; for (int k = threadIdx.x; k < D; k += 256) { const float v = H2[(size_t)row * D + k]; s += v * v; }
    const float r = rsqrtf(bsum(s, red) / D + EPS);
    for (int k = threadIdx.x; k < D; k += 256) EXF[(size_t)blockIdx.x * D + k] = H2[(size_t)row * D + k] * r * gfin[k];
}
__global__ void chk_final(const float* OUT, const float* EXF, float* F) {
    const int row = (int)((blockIdx.x * 2654435761u) % (unsigned)M); float e = 0.f;
    for (int k = threadIdx.x; k < D; k += 256) if (!(row == 0 && k == 0)) e = fmaxf(e, nerr(OUT[(size_t)row * D + k], EXF[(size_t)blockIdx.x * D + k], 0.001f, 0.001f));
    flag(F, 8, e);
}
__global__ void cksum(const unsigned* p, size_t nwords, unsigned long long* acc) {
    unsigned long long s = 0; for (size_t i = (size_t)blockIdx.x * blockDim.x + threadIdx.x; i < nwords; i += (size_t)gridDim.x * blockDim.x) { const unsigned w = p[i]; s += (unsigned long long)w * (unsigned long long)((i & 0xffff) + 1); }
    for (int o = 32; o > 0; o >>= 1) s += __shfl_down(s, o);
    if ((threadIdx.x & 63) == 0) atomicAdd(acc, s);
}
__global__ void ckcmp(const unsigned long long* a, const unsigned long long* b, int n, float* F, int k) { bool bad = false; for (int i = 0; i < n; ++i) bad |= a[i] != b[i]; if (bad) F[k] = 2.f; }
__global__ void report(const float* F, float* out, int base) {
    int code = 0; for (int k = 0; k < 6; ++k) if (!(F[base + k] <= 1.f)) code |= 1 << k;
    out[0] = 10.f * code + 5.f;
}
}
#endif

#if defined(MK_DEBUG) && MK_DEBUG >= 3
namespace nv {
constexpr int D = 1024, INW = 7424, F = 2816;
constexpr int O_AQ = 0, O_AK = 1024, O_AV = 1152, O_HQ = 1280, O_HF = 2304, O_HI = 3328, O_HG = 4352, O_GA = 5376, O_GB = 6400;
constexpr float EPS = 1e-6f;

__global__ void k_rmsnorm(const float* __restrict__ x, const float* __restrict__ g, float* __restrict__ out) {
    const int row = blockIdx.x, t = threadIdx.x;
    const float4 v = ((const float4*)(x + (size_t)row * D))[t];
    float s = v.x * v.x + v.y * v.y + v.z * v.z + v.w * v.w;
    __shared__ float red[256];
    red[t] = s; __syncthreads();
    for (int o = 128; o > 0; o >>= 1) { if (t < o) red[t] += red[t + o]; __syncthreads(); }
    const float r = rsqrtf(red[0] / D + EPS);
    const float4 gv = ((const float4*)g)[t];
    float4 o4; o4.x = v.x * r * gv.x; o4.y = v.y * r * gv.y; o4.z = v.z * r * gv.z; o4.w = v.w * r * gv.w;
    ((float4*)(out + (size_t)row * D))[t] = o4;
}

__global__ void k_gemm(const float* __restrict__ A, int lda, const float* __restrict__ W, int ldw, const float* __restrict__ bias,
                       const float* __restrict__ res, int ldres, float* __restrict__ C, int ldc, int K) {
    __shared__ float As[16][65], Ws[16][65];
    const int t = threadIdx.x, tx = t & 15, ty = t >> 4, m0 = blockIdx.y * 64, n0 = blockIdx.x * 64;
    float acc[4][4] = {};
    for (int k0 = 0; k0 < K; k0 += 16) {
        for (int i = t; i < 64 * 16; i += 256) { const int r = i >> 4, c = i & 15; As[c][r] = A[(size_t)(m0 + r) * lda + k0 + c]; }
        for (int i = t; i < 16 * 64; i += 256) { const int r = i >> 6, c = i & 63; Ws[r][c] = W[(size_t)(k0 + r) * ldw + n0 + c]; }
        __syncthreads();
#pragma unroll
        for (int k = 0; k < 16; ++k) {
            float a[4], b[4];
#pragma unroll
            for (int i = 0; i < 4; ++i) { a[i] = As[k][ty * 4 + i]; b[i] = Ws[k][tx * 4 + i]; }
#pragma unroll
            for (int i = 0; i < 4; ++i)
#pragma unroll
                for (int j = 0; j < 4; ++j) acc[i][j] += a[i] * b[j];
        }
        __syncthreads();
    }
#pragma unroll
    for (int i = 0; i < 4; ++i)
#pragma unroll
        for (int j = 0; j < 4; ++j) {
            const int m = m0 + ty * 4 + i, n = n0 + tx * 4 + j;
            float v = acc[i][j]; if (bias) v += bias[n]; if (res) v += res[(size_t)m * ldres + n];
            C[(size_t)m * ldc + n] = v;
        }
}

__global__ void k_attn(const float* __restrict__ p, const float* __restrict__ sinks, float* __restrict__ y, int S) {
    const int w = (blockIdx.x * blockDim.x + threadIdx.x) >> 6, d = threadIdx.x & 63;
    const int hq = w & 15, i = w >> 4, hkv = hq >> 3;
    const float q = p[(size_t)i * INW + O_AQ + hq * 64 + d];
    const int j0 = i - 127 < 0 ? 0 : i - 127;
    float m = sinks[hq], l = 1.f, o = 0.f;
    for (int j = j0; j <= i; ++j) {
        float s = q * p[(size_t)j * INW + O_AK + hkv * 64 + d];
#pragma unroll
        for (int x = 1; x < 64; x <<= 1) s += __shfl_xor(s, x);
        s *= 0.125f;
        const float mn = fmaxf(m, s), a = __expf(m - mn), e = __expf(s - mn);
        l = l * a + e; o = o * a + e * p[(size_t)j * INW + O_AV + hkv * 64 + d]; m = mn;
    }
    y[(size_t)i * D + hq * 64 + d] = o / l;
}

__global__ void k_hgrn(const float* __restrict__ p, const float* __restrict__ lbl, const float* __restrict__ ng, float* __restrict__ o_raw, int S) {
    const int h = blockIdx.x >> 3, vs = blockIdx.x & 7, t = threadIdx.x, kq = t >> 4, v = t & 15;
    __shared__ float part[16][17];
    float lb[8], st[8];
#pragma unroll
    for (int i = 0; i < 8; ++i) { const int ch = h * 128 + kq * 8 + i; const float l0 = lbl[ch], l1 = lbl[1024 + ch]; const float mx = fmaxf(l0, l1); const float e0 = __expf(l0 - mx), e1 = __expf(l1 - mx); lb[i] = e0 / (e0 + e1); st[i] = 0.f; }
    for (int tok = 0; tok < S; ++tok) {
        const float* row = p + (size_t)tok * INW;
        const float vv = row[O_HI + h * 128 + vs * 16 + v];
        float po = 0.f;
#pragma unroll
        for (int i = 0; i < 8; ++i) { const int ch = h * 128 + kq * 8 + i; const float fp = row[O_HF + ch], hq = row[O_HQ + ch];
            const float sg = 1.f / (1.f + __expf(-fp)); const float f = lb[i] + (1.f - lb[i]) * sg; const float kk = (1.f - lb[i]) * (1.f - sg); const float q = hq / (1.f + __expf(-hq));
            st[i] = f * st[i] + kk * vv; po += q * st[i]; }
        part[kq][v] = po; __syncthreads();
        if (t < 16) { float s = 0.f;
#pragma unroll
            for (int i = 0; i < 16; ++i) s += part[i][t];
            o_raw[(size_t)tok * D + h * 128 + vs * 16 + t] = s; }
        __syncthreads();
    }
}
__global__ void k_hgrn_post(const float* __restrict__ o_raw, const float* __restrict__ p, const float* __restrict__ ng, float* __restrict__ y) {
    const int tok = blockIdx.x >> 3, h = blockIdx.x & 7, t = threadIdx.x;
    const float o = o_raw[(size_t)tok * D + h * 128 + t];
    __shared__ float red[128]; red[t] = o * o; __syncthreads();
    for (int s = 64; s > 0; s >>= 1) { if (t < s) red[t] += red[t + s]; __syncthreads(); }
    const float r = rsqrtf(red[0] / 128.f + EPS); const float hg = p[(size_t)tok * INW + O_HG + h * 128 + t];
    y[(size_t)tok * D + h * 128 + t] = o * r * ng[h * 128 + t] / (1.f + __expf(-hg));
}
__global__ void k_merge(const float* __restrict__ p, const float* __restrict__ ya, const float* __restrict__ yb, float* __restrict__ mg) {
    const int idx = blockIdx.x * blockDim.x + threadIdx.x; const int tok = idx >> 10, c = idx & 1023;
    const float ga = p[(size_t)tok * INW + O_GA + c], gb = p[(size_t)tok * INW + O_GB + c];
    mg[idx] = ya[idx] / (1.f + __expf(-ga)) + yb[idx] / (1.f + __expf(-gb));
}
__global__ void k_swiglu(const float* __restrict__ g, const float* __restrict__ u, float* __restrict__ z, int n) {
    const int idx = blockIdx.x * blockDim.x + threadIdx.x; if (idx < n) { const float a = g[idx]; z[idx] = a / (1.f + __expf(-a)) * u[idx]; }
}
}
namespace dbg3 {
using dbg::flag; using dbg::nerr; using dbg::sg_;
constexpr int SR_ = 128;
__global__ void cmp_p1(const float* p, const float* lbl, const bf16* AQ, const bf16* AK, const bf16* AV, const bf16* Q1, const bf16* K1, const bf16* V, const bf16* SG, const bf16* SR, const bf16* SB, const float* BMID, const float* BLAST, float* F) {
    const int idx = blockIdx.x * blockDim.x + threadIdx.x, row = idx >> 10, c = idx & 1023; const float* pr = p + (size_t)row * nv::INW;
    flag(F, 0, nerr(bf2f(AQ[(size_t)row * D + c]), pr[c] * pg8::C2, 0.02f, 0.004f));
    if (c < 128) { flag(F, 0, nerr(bf2f(AK[(size_t)row * 128 + c]), pr[1024 + c], 0.02f, 0.02f)); flag(F, 0, nerr(bf2f(AV[(size_t)row * 128 + c]), pr[1152 + c], 0.02f, 0.02f)); }
    flag(F, 1, nerr(bf2f(V[(size_t)row * D + c]), pr[3328 + c], 0.02f, 0.02f)); flag(F, 1, nerr(bf2f(SG[(size_t)row * D + c]), sg_(pr[4352 + c]), 0.03f, 0.02f));
    flag(F, 2, nerr(bf2f(SB[(size_t)row * D + c]), sg_(pr[6400 + c]), 0.03f, 0.02f)); flag(F, 2, nerr(bf2f(SR[(size_t)row * D + c]), sg_(pr[5376 + c]) / sg_(pr[6400 + c]), 0.05f, 0.03f));
    const int ck = row >> 6, r0 = ck * 64; const float l0 = lbl[c], l1 = lbl[1024 + c], lb = 1.f / (1.f + __expf(l1 - l0));
    float cum = 0.f, bm = 0.f, bl = 0.f, brow = 0.f;
    for (int r = r0; r < r0 + 64; ++r) { const float s = sg_(p[(size_t)r * nv::INW + 2304 + c]); cum += log2f(lb + (1.f - lb) * s); if (r == row) brow = cum; if (r == r0 + 31) bm = cum; if (r == r0 + 63) bl = cum; }
    const float hq = pr[1280 + c], s = sg_(pr[2304 + c]);
    flag(F, 3, nerr(bf2f(Q1[(size_t)row * D + c]), hq * sg_(hq) * exp2f(brow - bm), 0.04f, 2e-2f * exp2f(brow - bm)));
    flag(F, 3, nerr(bf2f(K1[(size_t)row * D + c]), (1.f - lb) * (1.f - s) * exp2f(bm - brow), 0.04f, 2e-2f * exp2f(bm - brow)));
    flag(F, 3, nerr(BMID[(size_t)ck * 1024 + c], bm, 0.01f, 0.03f)); flag(F, 3, nerr(BLAST[(size_t)ck * 1024 + c], bl, 0.01f, 0.03f));
}
__global__ void cmp_bf(const bf16* got, const float* exp, int ld_exp, float rel, float abst, float* F, int k) {
    const int idx = blockIdx.x * blockDim.x + threadIdx.x, row = idx >> 10, c = idx & 1023; flag(F, k, nerr(bf2f(got[(size_t)row * D + c]), exp[(size_t)row * ld_exp + c], rel, abst));
}
__global__ void cmp_f32(const float* got, const float* exp, float rel, float abst, float* F, int k) {
    const int idx = blockIdx.x * blockDim.x + threadIdx.x; if (idx == 0) return; flag(F, k, nerr(got[idx], exp[idx], rel, abst));
}
__global__ void cmp_z(const bf16* got, const float* exp, float* F, int k, int n) {
    const int idx = blockIdx.x * blockDim.x + threadIdx.x; if (idx < n) flag(F, k, nerr(bf2f(got[idx]), exp[idx], 0.04f, 0.03f));
}
}
#endif

#if defined(MK_DEBUG) && MK_DEBUG == 4
namespace dbg4 {
__global__ void cmp_rows(const float* got, const float* exp, int row0, unsigned* ST) {
    __shared__ int cnt; if (threadIdx.x == 0) cnt = 0; __syncthreads();
    const int row = blockIdx.x; int bad = 0;
    for (int k = threadIdx.x; k < D; k += 256) { const float g = got[(size_t)(row0 + row) * D + k], e = exp[(size_t)row * D + k]; if (!(fabsf(g - e) <= 0.05f + 0.02f * fabsf(e))) ++bad; }
    if (bad) atomicAdd(&cnt, bad); __syncthreads();
    if (threadIdx.x == 0 && cnt > 0) { atomicAdd(ST + 0, 1u); atomicMin(ST + 1, (unsigned)(row0 + row)); atomicMax(ST + 2, (unsigned)(row0 + row)); atomicAdd(ST + 5, (unsigned)cnt); if (((row0 + row) & 15) == 15) atomicAdd(ST + 6, 1u); if (((row0 + row) & 63) == 63) atomicAdd(ST + 7, 1u); if (((row0 + row) & 15) == 0) atomicAdd(ST + 8, 1u); if (row0 + row >= 15360) atomicAdd(ST + 9, 1u); if (((row0 + row) & 4095) >= 3840) atomicAdd(ST + 10, 1u); if (((row0 + row) & 4095) < 256) atomicAdd(ST + 11, 1u); if ((row0 + row) & 1) atomicAdd(ST + 12, 1u); if ((row0 + row) & 8) atomicAdd(ST + 13, 1u); if (((row0 + row) & 127) < 8) atomicAdd(ST + 14, 1u); if (((row0 + row) & 63) < 8) atomicAdd(ST + 15, 1u); atomicMin(ST + 16, (unsigned)((row0 + row) & 127)); atomicMax(ST + 17, (unsigned)((row0 + row) & 127)); atomicMin(ST + 18, (unsigned)((row0 + row) & 2047)); atomicMax(ST + 19, (unsigned)((row0 + row) & 2047)); }
}
__global__ void cmp_cols(const float* got, const float* exp, int row0, int nrows, unsigned* ST) {
    const unsigned fr = ST[1]; if (fr < (unsigned)row0 || fr >= (unsigned)(row0 + nrows)) return;
    for (int k = threadIdx.x; k < D; k += 256) { const float g = got[(size_t)fr * D + k], e = exp[(size_t)(fr - row0) * D + k]; if (!(fabsf(g - e) <= 0.05f + 0.02f * fabsf(e))) { atomicAdd(ST + 3, 1u); atomicMin(ST + 4, (unsigned)k); } }
}
__global__ void report4(const unsigned* ST, float* out, int sel) { out[0] = 5.f + 10.f * (float)(sel == 5 ? ST[5] / 1024u : ST[sel]); }
}
#endif

#if defined(MK_DEBUG) && MK_DEBUG == 5
namespace dbg5 {
__global__ void nancount(const unsigned* p, size_t nwords, int f32mode, unsigned* CNT, int slot) {
    unsigned c = 0;
    for (size_t i = (size_t)blockIdx.x * blockDim.x + threadIdx.x; i < nwords; i += (size_t)gridDim.x * blockDim.x) { const unsigned w = p[i];
        if (f32mode == 1) { if ((w & 0x7f800000u) == 0x7f800000u) ++c; } else if (f32mode == 0) { if ((w & 0x7f80u) == 0x7f80u) ++c; if ((w & 0x7f800000u) == 0x7f800000u) ++c; }
        else { const float lo = __builtin_bit_cast(float, w << 16), hi = __builtin_bit_cast(float, w & 0xffff0000u); const bool b0 = !(fabsf(lo) <= 16.f), b1 = !(fabsf(hi) <= 16.f); if (b0) ++c; if (b1) ++c; if (b0 || b1) { const size_t e = 2 * i; if ((e & 1023) >= 896) atomicAdd(CNT + 20 + slot, 1u); atomicMin(CNT + 30 + slot, (unsigned)(e >> 10)); atomicMax(CNT + 40 + slot, (unsigned)(e >> 10)); atomicMin(CNT + 50 + slot, (unsigned)(e & 1023)); atomicMax(CNT + 60 + slot, (unsigned)(e & 1023)); const float mx = fmaxf(b0 ? fabsf(lo) : 0.f, b1 ? fabsf(hi) : 0.f); atomicMax(CNT + 70 + slot, (unsigned)fminf(mx, 1e6f)); atomicMin(CNT + 80 + slot, (unsigned)fminf(mx, 1e6f)); if (e >= 8) { const unsigned pw = p[i - 4]; if (!(fabsf(__builtin_bit_cast(float, pw << 16)) <= 16.f)) atomicAdd(CNT + 90 + slot, 1u); } } } }
    if (c) atomicAdd(CNT + slot, c);
}
__global__ void report5(const unsigned* CNT, float* out, int sel) {
    if (sel < 0) { int first = 0; for (int k = 0; k < 16; ++k) if (CNT[k] && !first) first = k + 1; out[0] = 5.f + 10.f * first; }
    else out[0] = 5.f + 10.f * (float)(CNT[sel] > 4000000u ? 4000000u : CNT[sel]);
}
}
#endif
#ifndef MK_N_LAUNCHES
#define MK_N_LAUNCHES 1
#endif
extern "C" void kernel_launch(void* const* d_in, const int* in_sizes, int n_in, void* d_out, int out_size, void* d_ws, size_t ws_size, hipStream_t stream) {
    static int grid = 0;
    if (grid == 0) {
        if (n_in != 15 || in_sizes[0] != M * D || out_size != M * D || ws_size < WS_END) { fprintf(stderr, "kernel_launch: unexpected shapes (n_in %d, in0 %d, out %d, ws %zu); nothing launched\n", n_in, n_in > 0 ? in_sizes[0] : -1, out_size, ws_size); grid = -1; return; }
        int dev = 0, cus = 0, per_cu = 0;
        if (hipGetDevice(&dev) != hipSuccess || hipDeviceGetAttribute(&cus, hipDeviceAttributeMultiprocessorCount, dev) != hipSuccess) { grid = -1; return; }
        if (hipFuncSetAttribute((const void*)mk_fwd, hipFuncAttributeMaxDynamicSharedMemorySize, LDS_BYTES) != hipSuccess) { fprintf(stderr, "kernel_launch: hipFuncSetAttribute failed\n"); grid = -1; return; }
        if (hipOccupancyMaxActiveBlocksPerMultiprocessor(&per_cu, (const void*)mk_fwd, NWAVES * 64, LDS_BYTES) != hipSuccess || per_cu < 1) { fprintf(stderr, "kernel_launch: occupancy query says %d blocks per CU\n", per_cu); per_cu = 1; }
        (void)hipGetLastError();
        grid = cus;
        if (grid != 256) fprintf(stderr, "kernel_launch: %d CUs (expected 256)\n", grid);
    }
    if (grid < 0) return;
    if (hipMemsetAsync((char*)d_ws + WS_CTL, 0, CTL_ZERO_BYTES, stream) != hipSuccess) return;
    Args a{};
    for (int i = 0; i < 15; ++i) a.in[i] = (const float*)d_in[i];
    a.out = (float*)d_out; a.ws = (unsigned char*)d_ws;
#define LAUNCH_PH(lo_, hi_) do { a.ph_lo = (lo_); a.ph_hi = (hi_); hipLaunchKernelGGL(mk_fwd, dim3(grid), dim3(NWAVES * 64), LDS_BYTES, stream, a); } while (0)
#if defined(MK_DEBUG) && MK_DEBUG == 5
    {
        using namespace dbg5; unsigned char* ws = (unsigned char*)d_ws; float* out = (float*)d_out;
        unsigned* CNT = (unsigned*)(ws + 250 * MiB);
        hipMemsetAsync(ws + 1 * MiB, 0xFF, 242 * MiB, stream); hipMemsetAsync(out, 0xFF, (size_t)M * D * 4, stream); hipMemsetAsync(CNT, 0, 512, stream); hipMemsetAsync(CNT + 30, 0xff, 40, stream); hipMemsetAsync(CNT + 50, 0xff, 40, stream); hipMemsetAsync(CNT + 80, 0xff, 40, stream);
#define NC(ptr, bytes, f32, slot) nancount<<<1024, 256, 0, stream>>>((const unsigned*)(ptr), (size_t)(bytes) / 4, (f32), CNT, (slot))
        LAUNCH_PH(0, 1); LAUNCH_PH(1, 2);
        NC(ws + WS_V, 32 * MiB, 2, 0); NC(ws + WS_SG, 32 * MiB, 2, 1); NC((unsigned char*)out + 32 * MiB, 32 * MiB, 2, 2); NC(ws + WS_AK, 8 * MiB, 2, 3);
        LAUNCH_PH(2, 3); NC(ws + WS_AQ, 32 * MiB, 2, 4); NC(ws + WS_SG, 32 * MiB, 2, 5);
        LAUNCH_PH(3, 4); NC(ws + WS_MG, 32 * MiB, 2, 6);
        LAUNCH_PH(4, 5); LAUNCH_PH(5, 6); LAUNCH_PH(6, 7); LAUNCH_PH(7, 8);
        report5<<<1, 1, 0, stream>>>(CNT, out, DBG3_BASE);
    }
#elif defined(MK_DEBUG) && MK_DEBUG == 4
    {
        using namespace dbg4; unsigned char* ws = (unsigned char*)d_ws; float* out = (float*)d_out; constexpr int S = SEQ;
        LAUNCH_PH(0, N_PHASES);
        float* SAVE = (float*)(ws + 180 * MiB); unsigned* ST = (unsigned*)(ws + 250 * MiB);
        hipMemcpyAsync(SAVE, out, (size_t)M * D * 4, hipMemcpyDeviceToDevice, stream);
        hipMemsetAsync(ST, 0, 128, stream); hipMemsetAsync(ST + 1, 0xff, 4, stream); hipMemsetAsync(ST + 4, 0xff, 4, stream); hipMemsetAsync(ST + 16, 0xff, 4, stream); hipMemsetAsync(ST + 18, 0xff, 4, stream);
        const float* x = a.in[0]; const size_t SD = (size_t)S * D; float* w = (float*)ws;
        float* U = w; float* P = U + SD; float* YAT = P + (size_t)S * nv::INW; float* YHG = YAT + SD; float* ORAW = YHG + SD;
        for (int b = 0; b < BATCH; ++b) {
            const float* xb = x + (size_t)b * SD;
            nv::k_rmsnorm<<<S, 256, 0, stream>>>(xb, a.in[1], U);
            nv::k_gemm<<<dim3(nv::INW / 64, S / 64), 256, 0, stream>>>(U, D, a.in[2], nv::INW, a.in[3], nullptr, 0, P, nv::INW, D);
            nv::k_attn<<<S * 16 / 4, 256, 0, stream>>>(P, a.in[4], YAT, S);
            nv::k_hgrn<<<64, 256, 0, stream>>>(P, a.in[5], a.in[6], ORAW, S);
            nv::k_hgrn_post<<<S * 8, 128, 0, stream>>>(ORAW, P, a.in[6], YHG);
            nv::k_gemm<<<dim3(D / 64, S / 64), 256, 0, stream>>>(YAT, D, a.in[7], D, nullptr, nullptr, 0, U, D, D);
            nv::k_gemm<<<dim3(D / 64, S / 64), 256, 0, stream>>>(YHG, D, a.in[8], D, nullptr, nullptr, 0, ORAW, D, D);
            nv::k_merge<<<S * D / 256, 256, 0, stream>>>(P, U, ORAW, YAT);
            nv::k_gemm<<<dim3(D / 64, S / 64), 256, 0, stream>>>(YAT, D, a.in[9], D, nullptr, xb, D, YHG, D, D);
            nv::k_rmsnorm<<<S, 256, 0, stream>>>(YHG, a.in[10], U);
            float* GT = P; float* UP = P + (size_t)S * nv::F; float* Z = UP + (size_t)S * nv::F;
            nv::k_gemm<<<dim3(nv::F / 64, S / 64), 256, 0, stream>>>(U, D, a.in[11], nv::F, nullptr, nullptr, 0, GT, nv::F, D);
            nv::k_gemm<<<dim3(nv::F / 64, S / 64), 256, 0, stream>>>(U, D, a.in[12], nv::F, nullptr, nullptr, 0, UP, nv::F, D);
            nv::k_swiglu<<<(S * nv::F + 255) / 256, 256, 0, stream>>>(GT, UP, Z, S * nv::F);
            nv::k_gemm<<<dim3(D / 64, S / 64), 256, 0, stream>>>(Z, nv::F, a.in[13], D, nullptr, YHG, D, ORAW, D, nv::F);
            nv::k_rmsnorm<<<S, 256, 0, stream>>>(ORAW, a.in[14], U);
            cmp_rows<<<S, 256, 0, stream>>>(SAVE, U, b * S, ST);
            cmp_cols<<<1, 256, 0, stream>>>(SAVE, U, b * S, S, ST);
        }
        report4<<<1, 1, 0, stream>>>(ST, out, DBG3_BASE);
    }
#elif defined(MK_DEBUG) && MK_DEBUG == 3
    {
        using namespace dbg3; unsigned char* ws = (unsigned char*)d_ws; float* out = (float*)d_out; constexpr int S3 = SR_;
        const float* x = a.in[0]; const float* sinks = a.in[4]; const float* lbl = a.in[5]; const float* ng = a.in[6];
        bf16* AQ = (bf16*)(ws + WS_AQ); bf16* AK = (bf16*)(ws + WS_AK); bf16* AV = (bf16*)(ws + WS_AV); bf16* Q1 = (bf16*)(ws + WS_Q1); bf16* K1 = (bf16*)(ws + WS_K1); bf16* V = (bf16*)(ws + WS_V); bf16* SG = (bf16*)(ws + WS_SG);
        bf16* MG = (bf16*)(ws + WS_MG); bf16* SR = (bf16*)out; bf16* SB = SR + (size_t)M * D; float* BMID = (float*)(ws + WS_BM); float* BLAST = (float*)(ws + WS_BL);
        float* FL = (float*)(ws + 243 * MiB); float* nb = (float*)(ws + 243 * MiB + 65536);
        float* nu = nb; float* np_ = nu + S3 * D; float* nyat = np_ + (size_t)S3 * nv::INW; float* nyhg = nyat + S3 * D; float* noraw = nyhg + S3 * D; float* nya = noraw + S3 * D; float* nyb = nya + S3 * D;
        float* nmg = nyb + S3 * D; float* nh1 = nmg + S3 * D; float* nfin = nh1 + S3 * D; float* ngt = nu; float* nup = nya; float* nz = nyat; float* nh2 = nmg;
        hipMemsetAsync(FL, 0, 256, stream);
        nv::k_rmsnorm<<<S3, 256, 0, stream>>>(x, a.in[1], nu);
        nv::k_gemm<<<dim3(nv::INW / 64, S3 / 64), 256, 0, stream>>>(nu, D, a.in[2], nv::INW, a.in[3], nullptr, 0, np_, nv::INW, D);
        nv::k_attn<<<S3 * 16 / 4, 256, 0, stream>>>(np_, sinks, nyat, S3);
        nv::k_hgrn<<<64, 256, 0, stream>>>(np_, lbl, ng, noraw, S3);
        nv::k_hgrn_post<<<S3 * 8, 128, 0, stream>>>(noraw, np_, ng, nyhg);
        nv::k_gemm<<<dim3(D / 64, S3 / 64), 256, 0, stream>>>(nyat, D, a.in[7], D, nullptr, nullptr, 0, nya, D, D);
        nv::k_gemm<<<dim3(D / 64, S3 / 64), 256, 0, stream>>>(nyhg, D, a.in[8], D, nullptr, nullptr, 0, nyb, D, D);
        nv::k_merge<<<S3 * D / 256, 256, 0, stream>>>(np_, nya, nyb, nmg);
        nv::k_gemm<<<dim3(D / 64, S3 / 64), 256, 0, stream>>>(nmg, D, a.in[9], D, nullptr, x, D, nh1, D, D);
        LAUNCH_PH(0, 1); LAUNCH_PH(1, 2);
        cmp_p1<<<S3 * 1024 / 256, 256, 0, stream>>>(np_, lbl, AQ, AK, AV, Q1, K1, V, SG, SR, SB, BMID, BLAST, FL);
        LAUNCH_PH(2, 3);
        cmp_bf<<<S3 * 1024 / 256, 256, 0, stream>>>(AQ, nyat, D, 0.03f, 0.02f, FL, 4);
        cmp_bf<<<S3 * 1024 / 256, 256, 0, stream>>>(SG, nyhg, D, 0.05f, 0.03f, FL, 5);
        LAUNCH_PH(3, 4);
        cmp_bf<<<S3 * 1024 / 256, 256, 0, stream>>>(MG, nmg, D, 0.04f, 0.03f, FL, 6);
        LAUNCH_PH(4, 5);
        cmp_f32<<<S3 * 1024 / 256, 256, 0, stream>>>(out, nh1, 0.01f, 0.03f, FL, 7);
        nv::k_rmsnorm<<<S3, 256, 0, stream>>>(nh1, a.in[10], nfin);
        nv::k_gemm<<<dim3(nv::F / 64, S3 / 64), 256, 0, stream>>>(nfin, D, a.in[11], nv::F, nullptr, nullptr, 0, ngt, nv::F, D);
        nv::k_gemm<<<dim3(nv::F / 64, S3 / 64), 256, 0, stream>>>(nfin, D, a.in[12], nv::F, nullptr, nullptr, 0, nup, nv::F, D);
        nv::k_swiglu<<<(S3 * nv::F + 255) / 256, 256, 0, stream>>>(ngt, nup, nz, S3 * nv::F);
        LAUNCH_PH(5, 6);
        cmp_z<<<(S3 * 2816 + 255) / 256, 256, 0, stream>>>((bf16*)(ws + WS_Z), nz, FL, 8, S3 * 2816);
        nv::k_gemm<<<dim3(D / 64, S3 / 64), 256, 0, stream>>>(nz, nv::F, a.in[13], D, nullptr, nh1, D, nh2, D, nv::F);
        LAUNCH_PH(6, 7);
        cmp_f32<<<S3 * 1024 / 256, 256, 0, stream>>>(out, nh2, 0.01f, 0.03f, FL, 9);
        dbg::report<<<1, 1, 0, stream>>>(FL, out, DBG3_BASE);
    }
#elif defined(MK_DEBUG) && MK_DEBUG == 2
    {
        using namespace dbg; unsigned char* ws = (unsigned char*)d_ws; float* out = (float*)d_out;
        float* FL = (float*)(ws + WS_FLAGS); unsigned long long* CK = (unsigned long long*)(ws + WS_FLAGS + 4096);
        hipMemsetAsync(FL, 0, 8192, stream);
        int slot = 0;
#define CKS(ptr, bytes) do { cksum<<<1024, 256, 0, stream>>>((const unsigned*)(ptr), (size_t)(bytes) / 4, CK + slot); ++slot; } while (0)
#define CMP(n, bit) do { ckcmp<<<1, 1, 0, stream>>>(CK + slot - 2 * (n), CK + slot - (n), (n), FL, (bit)); } while (0)
        LAUNCH_PH(0, 1); CKS(ws + WS_WIN, 70 * MiB); LAUNCH_PH(0, 1); CKS(ws + WS_WIN, 70 * MiB); CMP(1, 0);
        LAUNCH_PH(1, 2); CKS(ws + WS_AQ, 168 * MiB); CKS(out, 64 * MiB); CKS(ws + WS_BM, 2 * MiB);
        LAUNCH_PH(1, 2); CKS(ws + WS_AQ, 168 * MiB); CKS(out, 64 * MiB); CKS(ws + WS_BM, 2 * MiB); CMP(3, 1);
        LAUNCH_PH(2, 3); CKS(ws + WS_AQ, 32 * MiB); CKS(ws + WS_SG, 32 * MiB);
        LAUNCH_PH(1, 2); LAUNCH_PH(2, 3); CKS(ws + WS_AQ, 32 * MiB); CKS(ws + WS_SG, 32 * MiB); CMP(2, 2);
        LAUNCH_PH(3, 4); CKS(ws + WS_MG, 32 * MiB); LAUNCH_PH(3, 4); CKS(ws + WS_MG, 32 * MiB); CMP(1, 3);
        LAUNCH_PH(4, 5); CKS(out, 64 * MiB); CKS(ws + WS_XN, 32 * MiB); CKS(ws + WS_SSQ, 1 * MiB);
        LAUNCH_PH(4, 5); CKS(out, 64 * MiB); CKS(ws + WS_XN, 32 * MiB); CKS(ws + WS_SSQ, 1 * MiB); CMP(3, 4);
        LAUNCH_PH(5, 6); CKS(ws + WS_Z, 88 * MiB); LAUNCH_PH(5, 6); CKS(ws + WS_Z, 88 * MiB); CMP(1, 5);
        LAUNCH_PH(6, 7); LAUNCH_PH(7, 8);
        report<<<1, 1, 0, stream>>>(FL, out, 0);
    }
#elif defined(MK_DEBUG)
    {
        using namespace dbg; unsigned char* ws = (unsigned char*)d_ws; float* out = (float*)d_out;
        const float* x = a.in[0]; const float* g = a.in[1]; const float* w_in = a.in[2]; const float* b_in = a.in[3]; const float* sinks = a.in[4]; const float* lbl = a.in[5]; const float* ng = a.in[6];
        bf16* AQ = (bf16*)(ws + WS_AQ); bf16* AK = (bf16*)(ws + WS_AK); bf16* AV = (bf16*)(ws + WS_AV); bf16* Q1 = (bf16*)(ws + WS_Q1); bf16* K1 = (bf16*)(ws + WS_K1); bf16* V = (bf16*)(ws + WS_V); bf16* SG = (bf16*)(ws + WS_SG);
        bf16* MG = (bf16*)(ws + WS_MG); bf16* SR = (bf16*)out; bf16* SB = SR + (size_t)M * D; float* BMID = (float*)(ws + WS_BM); float* BLAST = (float*)(ws + WS_BL); float* SSQ = (float*)(ws + WS_SSQ);
        float* FL = (float*)(ws + WS_FLAGS); float* EX = (float*)(ws + WS_EXP_ATT); float* PS = (float*)(ws + WS_PSM);
        hipMemsetAsync(FL, 0, 256, stream);
        LAUNCH_PH(0, 1); LAUNCH_PH(1, 2);
        chk_p1<<<2048, 256, 0, stream>>>(x, g, w_in, b_in, AQ, AK, AV, V, SG, SR, SB, FL);
        chk_p1h<<<128, 256, 0, stream>>>(x, g, w_in, b_in, lbl, Q1, K1, BMID, BLAST, FL);
        exp_attn<<<NS_ATT / 4, 256, 0, stream>>>(AQ, AK, AV, sinks, EX);
        exp_hgrn_p<<<HG_TOK, 256, 0, stream>>>(x, g, w_in, b_in, 3, 7, PS);
        LAUNCH_PH(2, 3);
        chk_attn<<<NS_ATT / 4, 256, 0, stream>>>(AQ, EX, FL);
        chk_hgrn<<<1, 512, 0, stream>>>(PS, lbl, ng, SG, 3, 7, FL);
        LAUNCH_PH(3, 4);
        chk_mg<<<64, 256, 0, stream>>>(AQ, SG, SR, SB, a.in[7], a.in[8], MG, FL);
        LAUNCH_PH(4, 5);
        chk_h1<<<64, 256, 0, stream>>>(x, MG, a.in[9], out, SSQ, FL);
        LAUNCH_PH(5, 6);
        chk_z<<<2048, 256, 0, stream>>>(out, a.in[10], a.in[11], a.in[12], (bf16*)(ws + WS_Z), FL);
        LAUNCH_PH(6, 7);
        chk_h2<<<64, 256, 0, stream>>>((bf16*)(ws + WS_XN), (bf16*)(ws + WS_Z), a.in[13], out, FL);
        exp_final<<<NS_FIN, 256, 0, stream>>>(out, a.in[14], (float*)(ws + WS_EXP_FIN));
        LAUNCH_PH(7, 8);
        chk_final<<<NS_FIN, 256, 0, stream>>>(out, (float*)(ws + WS_EXP_FIN), FL);
        report<<<1, 1, 0, stream>>>(FL, out, 2);
    }
#elif MK_N_LAUNCHES == 1
    LAUNCH_PH(0, N_PHASES);
#else
    for (int p = 0; p < N_PHASES; ++p) LAUNCH_PH(p, p + 1);
#endif
}
```
